# Optimizing an MI355X kernel written in HIP

```python
import math
import jax, jax.numpy as jnp
from jax import lax
import numpy as np

D_MODEL = 1024
BATCH = 8
SEQ = 2048
DEPTH = 2

N_MIXERS = 2
HEAD_DIM = 64
ATTN_HEADS = D_MODEL // HEAD_DIM
ATTN_WIDTH = ATTN_HEADS * HEAD_DIM
DILATED_GROUPS = ((128, 1), (512, 4), (2048, 16))
N_GROUPS_A = len(DILATED_GROUPS)
ATTN_IN_COLS = 3 * N_GROUPS_A * ATTN_WIDTH + ATTN_WIDTH
REL_BUCKETS = 32
REL_MAX_DIST = 2048
SSM_WIDTH = D_MODEL
SSM_GROUP = 16
SSM_N_GROUPS = SSM_WIDTH // SSM_GROUP
SSM_STATE = 64
N_ATTN_LAYERS = (DEPTH + 1) // 2
N_SSM_LAYERS = DEPTH // 2
EPS = 1e-6
NEG = -1e30

kernel_name = "hybrid_dilated_attn_s5_interleaved"


def rms_norm(x, g):
    xf = x.astype(jnp.float32)
    y = xf * lax.rsqrt(jnp.mean(xf * xf, axis=-1, keepdims=True) + EPS) * g.astype(jnp.float32)
    return y.astype(x.dtype)


def t5_bucket(dist):
    max_exact = REL_BUCKETS // 2
    n = jnp.maximum(dist, 1).astype(jnp.float32)
    large = max_exact + (jnp.log(n / max_exact) / math.log(REL_MAX_DIST / max_exact)
                         * (REL_BUCKETS - max_exact)).astype(jnp.int32)
    large = jnp.minimum(large, REL_BUCKETS - 1)
    return jnp.where(dist < max_exact, dist, large)


def dilated_group_attention(q, k, v, rel_bias, window, dilation):
    B, S, H, E = q.shape
    steps = window // dilation
    blk = steps
    L = S // dilation
    nb = -(-L // blk)
    Lp = nb * blk

    def to_sub(t):
        t = t.reshape(B, L, dilation, H, E)
        return jnp.pad(t, ((0, 0), (0, Lp - L), (0, 0), (0, 0), (0, 0)))

    qs = to_sub(q).reshape(B, nb, blk, dilation, H, E)
    front = ((0, 0), (blk, 0), (0, 0), (0, 0), (0, 0))
    ks = jnp.pad(to_sub(k), front).reshape(B, nb + 1, blk, dilation, H, E)
    vs = jnp.pad(to_sub(v), front).reshape(B, nb + 1, blk, dilation, H, E)
    kw = jnp.concatenate([ks[:, :-1], ks[:, 1:]], axis=2)
    vw = jnp.concatenate([vs[:, :-1], vs[:, 1:]], axis=2)

    i = jnp.arange(blk)[:, None]
    j = jnp.arange(2 * blk)[None, :]
    back = blk + i - j
    band = (back >= 0) & (back <= steps)
    valid = band[None] & ((jnp.arange(nb)[:, None, None] > 0) | (j[None] >= blk))
    bias = rel_bias[t5_bucket(jnp.maximum(back, 0) * dilation)]
    bias = jnp.transpose(bias, (2, 0, 1)).astype(jnp.float32)

    scale = HEAD_DIM ** -0.5
    logits = jnp.einsum('bnqrhe,bnkrhe->bnrhqk', qs, kw,
                        preferred_element_type=jnp.float32) * scale + bias
    logits = jnp.where(valid[None, :, None, None], logits, NEG)
    lse = jax.nn.logsumexp(logits, axis=-1)
    p = jnp.exp(logits - lse[..., None])
    o = jnp.einsum('bnrhqk,bnkrhe->bnqrhe', p.astype(v.dtype), vw)
    o = o.reshape(B, Lp, dilation, H, E)[:, :L].reshape(B, S, H, E)
    lse = jnp.transpose(lse, (0, 1, 4, 2, 3)).reshape(B, Lp, dilation, H)[:, :L].reshape(B, S, H)
    return o, lse


def dilated_attention_mixer(h, w_in, w_out, rel_bias):
    B, S, _ = h.shape
    proj = h @ w_in
    n_qkv = 3 * N_GROUPS_A * ATTN_WIDTH
    qkv = proj[..., :n_qkv].reshape(B, S, 3, N_GROUPS_A, ATTN_HEADS, HEAD_DIM)
    z = proj[..., n_qkv:]
    outs, lses = [], []
    for g, (window, dilation) in enumerate(DILATED_GROUPS):
        o, l = dilated_group_attention(qkv[:, :, 0, g], qkv[:, :, 1, g], qkv[:, :, 2, g],
                                       rel_bias, window, dilation)
        outs.append(o)
        lses.append(l)
    wts = jax.nn.softmax(jnp.stack(lses), axis=0)
    o = jnp.sum(wts[..., None] * jnp.stack(outs).astype(jnp.float32), axis=0)
    o = o.reshape(B, S, ATTN_WIDTH).astype(h.dtype)
    return (o * jax.nn.silu(z)) @ w_out


def s5_scan(u, a_re, a_im, log_dt, b_re, b_im, c_re, c_im, d_skip):
    B, S, _ = u.shape
    f = jnp.float32
    uf = u.astype(f).reshape(B, S, SSM_N_GROUPS, SSM_GROUP)
    A = lax.complex(a_re.astype(f), a_im.astype(f))
    dt = jnp.exp(log_dt.astype(f))[:, None]
    a_bar = jnp.exp(A * dt)
    Bm = lax.complex(b_re.astype(f), b_im.astype(f))
    b_bar = ((a_bar - 1.0) / A)[..., None] * Bm
    bu = jnp.einsum('bsgc,gpc->bsgp', uf.astype(jnp.complex64), b_bar)
    a_elems = jnp.broadcast_to(a_bar, bu.shape)

    def combine(left, right):
        return (right[0] * left[0], right[0] * left[1] + right[1])

    _, states = lax.associative_scan(combine, (a_elems, bu), axis=1)
    Cm = lax.complex(c_re.astype(f), c_im.astype(f))
    y = jnp.einsum('bsgp,gcp->bsgc', states, Cm).real
    y = y + d_skip.astype(f).reshape(SSM_N_GROUPS, SSM_GROUP) * uf
    return y.reshape(B, S, SSM_WIDTH).astype(u.dtype)


def s5_mixer(h, w_in, a_re, a_im, log_dt, b_re, b_im, c_re, c_im, d_skip, w_glu, b_glu, w_out):
    proj = h @ w_in
    u, z = proj[..., :SSM_WIDTH], proj[..., SSM_WIDTH:]
    y = s5_scan(u, a_re, a_im, log_dt, b_re, b_im, c_re, c_im, d_skip)
    g = jax.nn.gelu(y)
    y = g * jax.nn.sigmoid(g @ w_glu + b_glu)
    return (y * jax.nn.silu(z)) @ w_out


def setup_inputs(seed: int = 0) -> dict:
    key = jax.random.key(seed)
    ks = jax.random.split(key, 24)
    nrm = jax.random.normal
    f = jnp.float32
    NA, NS, D = N_ATTN_LAYERS, N_SSM_LAYERS, D_MODEL
    G, P, C, E = SSM_N_GROUPS, SSM_STATE, SSM_GROUP, SSM_WIDTH
    x = nrm(ks[0], (BATCH, SEQ, D), f)
    rel_bias = 0.5 * nrm(ks[1], (REL_BUCKETS, ATTN_HEADS), f)
    attn_pre_norm = 1.0 + 0.05 * nrm(ks[2], (NA, D), f)
    attn_w_in = nrm(ks[3], (NA, D, ATTN_IN_COLS), f) * D ** -0.5
    attn_w_out = nrm(ks[4], (NA, ATTN_WIDTH, D), f) * ATTN_WIDTH ** -0.5
    attn_post_norm = 1.0 + 0.05 * nrm(ks[5], (NA, D), f)
    ssm_pre_norm = 1.0 + 0.05 * nrm(ks[6], (NS, D), f)
    ssm_w_in = nrm(ks[7], (NS, D, 2 * E), f) * D ** -0.5
    ssm_a_re = -0.5 + 0.01 * nrm(ks[8], (NS, G, P), f)
    ssm_a_im = math.pi * jnp.arange(P, dtype=f)[None, None, :] + 0.01 * nrm(ks[9], (NS, G, P), f)
    ssm_log_dt = jax.random.uniform(ks[10], (NS, G), f, math.log(1e-3), math.log(1e-1))
    ssm_b_re = nrm(ks[11], (NS, G, P, C), f) * (2 * C) ** -0.5
    ssm_b_im = nrm(ks[12], (NS, G, P, C), f) * (2 * C) ** -0.5
    ssm_c_re = nrm(ks[13], (NS, G, C, P), f) * (2 * P) ** -0.5
    ssm_c_im = nrm(ks[14], (NS, G, C, P), f) * (2 * P) ** -0.5
    ssm_d = nrm(ks[15], (NS, E), f)
    ssm_w_glu = nrm(ks[16], (NS, E, E), f) * E ** -0.5
    ssm_b_glu = 0.02 * nrm(ks[17], (NS, E), f)
    ssm_w_out = nrm(ks[18], (NS, E, D), f) * E ** -0.5
    ssm_post_norm = 1.0 + 0.05 * nrm(ks[19], (NS, D), f)
    return {"x": x, "rel_bias": rel_bias,
            "attn_pre_norm": attn_pre_norm, "attn_w_in": attn_w_in,
            "attn_w_out": attn_w_out, "attn_post_norm": attn_post_norm,
            "ssm_pre_norm": ssm_pre_norm, "ssm_w_in": ssm_w_in,
            "ssm_a_re": ssm_a_re, "ssm_a_im": ssm_a_im, "ssm_log_dt": ssm_log_dt,
            "ssm_b_re": ssm_b_re, "ssm_b_im": ssm_b_im,
            "ssm_c_re": ssm_c_re, "ssm_c_im": ssm_c_im, "ssm_d": ssm_d,
            "ssm_w_glu": ssm_w_glu, "ssm_b_glu": ssm_b_glu,
            "ssm_w_out": ssm_w_out, "ssm_post_norm": ssm_post_norm}


def reference(x, rel_bias, attn_pre_norm, attn_w_in, attn_w_out, attn_post_norm,
              ssm_pre_norm, ssm_w_in, ssm_a_re, ssm_a_im, ssm_log_dt,
              ssm_b_re, ssm_b_im, ssm_c_re, ssm_c_im, ssm_d,
              ssm_w_glu, ssm_b_glu, ssm_w_out, ssm_post_norm):
    for i in range(DEPTH):
        j = i // N_MIXERS
        if i % N_MIXERS == 0:
            h = rms_norm(x, attn_pre_norm[j])
            h = dilated_attention_mixer(h, attn_w_in[j], attn_w_out[j], rel_bias)
            x = x + rms_norm(h, attn_post_norm[j])
        else:
            h = rms_norm(x, ssm_pre_norm[j])
            h = s5_mixer(h, ssm_w_in[j], ssm_a_re[j], ssm_a_im[j], ssm_log_dt[j],
                         ssm_b_re[j], ssm_b_im[j], ssm_c_re[j], ssm_c_im[j], ssm_d[j],
                         ssm_w_glu[j], ssm_b_glu[j], ssm_w_out[j])
            x = x + rms_norm(h, ssm_post_norm[j])
    return x
```

```cpp
#include <hip/hip_runtime.h>
#include <cstdio>
#include <cstdint>

#ifndef MK_N_LAUNCHES
#define MK_N_LAUNCHES 12
#endif

#define GAS __attribute__((address_space(1)))
#define LAS __attribute__((address_space(3)))
typedef unsigned short bf16;
typedef short bf16x8 __attribute__((ext_vector_type(8)));
typedef float f32x4 __attribute__((ext_vector_type(4)));
typedef float f32x16 __attribute__((ext_vector_type(16)));
typedef unsigned u32x4 __attribute__((ext_vector_type(4)));
typedef unsigned u32x2 __attribute__((ext_vector_type(2)));
typedef GAS unsigned gu32;

constexpr int BATCH = 8, SEQ = 2048, D = 1024, M = BATCH * SEQ;
constexpr int NIN = 10240;
constexpr int HM = M / 2;
constexpr int NPH = 12;
constexpr int N_LAUNCHES = MK_N_LAUNCHES;
constexpr float EPS = 1e-6f;
constexpr float LOG2E = 1.4426950408889634f;
constexpr float C2 = 0.125f * LOG2E;

constexpr size_t MiB = 1u << 20;
constexpr size_t WS_CTL = 0, CTL_ZERO_BYTES = 1 * MiB;
constexpr size_t WS_WT_IN = 2 * MiB, WS_WT_AO = 22 * MiB, WS_WT_SI = 24 * MiB, WS_WT_GLU = 28 * MiB, WS_WT_SO = 30 * MiB;
constexpr size_t WS_W1 = 32 * MiB, WS_WY = 36 * MiB;
constexpr size_t WS_SMALL = 48 * MiB;
constexpr size_t WS_OG = 49 * MiB;
constexpr size_t WS_Q = 81 * MiB, WS_K = 129 * MiB, WS_VT = 177 * MiB, WS_SZ = 225 * MiB;
constexpr size_t WS_H2 = 81 * MiB;
constexpr size_t WS_XN2 = 145 * MiB, WS_UG = 177 * MiB, WS_SZ2 = 209 * MiB;
constexpr size_t WS_GB = 81 * MiB, WS_Y2 = 113 * MiB, WS_H3 = 145 * MiB;
constexpr size_t WS_END = 256 * MiB;
constexpr int SM_LAM = 0;
constexpr int SM_LAMT = SM_LAM + 64 * 64 * 2;
constexpr int SM_BBAR = SM_LAMT + 64 * 64 * 2;
constexpr int SM_BIAS = SM_BBAR + 64 * 64 * 16 * 2;
constexpr int SM_END = SM_BIAS + 3 * 16 * 192;
static_assert((size_t)SM_END * 4 <= 1 * MiB, "small tables");
constexpr int CW_BAR = 4096;

constexpr int RING_BYTES = 131072;
constexpr int LDSCTL_OFF = RING_BYTES, MISC_OFF = LDSCTL_OFF + 320;
constexpr int LDS_BYTES = 147456;

#define RLX_AGENT __ATOMIC_RELAXED, __HIP_MEMORY_SCOPE_AGENT
__device__ __forceinline__ unsigned f2bf(float f) { unsigned u = __builtin_bit_cast(unsigned, f); return (u + 0x7fffu + ((u >> 16) & 1u)) >> 16; }
__device__ __forceinline__ unsigned pk2(float lo, float hi) { return f2bf(lo) | (f2bf(hi) << 16); }
__device__ __forceinline__ float bf2f(bf16 b) { return __builtin_bit_cast(float, ((unsigned)b) << 16); }
__device__ __forceinline__ float silu_f(float z) { return z / (1.f + __expf(-z)); }
__device__ __forceinline__ float sigmoid_f(float z) { return 1.f / (1.f + __expf(-z)); }
__device__ __forceinline__ float gelu_tanh_f(float x) { const float u = 0.7978845608028654f * (x + 0.044715f * x * x * x); const float t = 1.f - 2.f / (__expf(2.f * u) + 1.f); return 0.5f * x * (1.f + t); }
__device__ __forceinline__ float wave_sum(float v) {
#pragma unroll
    for (int o = 1; o < 64; o <<= 1) v += __shfl_xor(v, o);
    return v;
}
__device__ __forceinline__ float wave_max(float v) {
#pragma unroll
    for (int o = 1; o < 64; o <<= 1) v = fmaxf(v, __shfl_xor(v, o));
    return v;
}

#define XB_TMO      128
#define XB_XCNT(j)  (256  + 64 * (j))
#define XB_XSUB(j)  (1280 + 64 * (j))
#define XB_XGEN(j)  (2304 + 64 * (j))
#define XB_TOP      3328
#define XB_TOPGEN   3392
#define XCD_BAR_WORDS 3456
#define XB_SPIN_CAP (1u << 22)
__device__ __forceinline__ unsigned xb_ld(unsigned* p)              { return __hip_atomic_load(p, __ATOMIC_RELAXED, __HIP_MEMORY_SCOPE_AGENT); }
__device__ __forceinline__ unsigned xb_add(unsigned* p, unsigned v) { return __hip_atomic_fetch_add(p, v, __ATOMIC_RELAXED, __HIP_MEMORY_SCOPE_AGENT); }
__device__ __forceinline__ unsigned xb_xcc_id() { return (unsigned)__builtin_amdgcn_s_getreg((3 << 11) | 20) & 0xFu; }
#define XB_SPIN(cond, bar) do { unsigned _sp = 0; while (cond) { __builtin_amdgcn_s_sleep(1); \
    if ((++_sp & 255u) == 0u) { if (xb_ld(&(bar)[XB_TMO])) break; if (_sp > XB_SPIN_CAP) { atomicAdd(&(bar)[XB_TMO], 1u); break; } } } } while (0)
struct XcdBarrier { unsigned* bar; unsigned x; volatile LAS unsigned* st; };
__device__ __forceinline__ XcdBarrier xcd_barrier_post(unsigned* bar, volatile LAS unsigned* st) {
    XcdBarrier b; b.bar = bar; b.x = xb_xcc_id(); b.st = st;
    if (threadIdx.x == 0) (void)xb_add(&bar[XB_XCNT(b.x)], 1u);
    return b;
}
__device__ __forceinline__ void xcd_barrier_complete(unsigned* bar, unsigned x, unsigned& nloc, unsigned& nx) {
    const unsigned G = gridDim.x * gridDim.y * gridDim.z;
    unsigned sum, cnt, mine, sp = 0u;
    for (;;) {
        sum = 0u; cnt = 0u; mine = 0u;
#pragma unroll
        for (unsigned j = 0; j < 16; ++j) { const unsigned c = xb_ld(&bar[XB_XCNT(j)]); sum += c; cnt += (c > 0u) ? 1u : 0u; mine = (j == x) ? c : mine; }
        if (sum == G) break;
        __builtin_amdgcn_s_sleep(1);
        if ((++sp & 255u) == 0u) { if (xb_ld(&bar[XB_TMO])) break; if (sp > XB_SPIN_CAP) { atomicAdd(&bar[XB_TMO], 1u); break; } }
    }
    nloc = mine > 0u ? mine : 1u; nx = cnt > 0u ? cnt : 1u;
}
__device__ __forceinline__ void xcd_barrier(const XcdBarrier& b) {
    asm volatile("s_waitcnt vmcnt(0)" ::: "memory");
    __syncthreads();
    if (threadIdx.x == 0) {
        unsigned* bar = b.bar;
        __builtin_amdgcn_s_waitcnt(0);
        unsigned nloc = b.st[0], nx = b.st[1];
        if (nloc == 0u) { xcd_barrier_complete(bar, b.x, nloc, nx); b.st[0] = nloc; b.st[1] = nx; }
        const unsigned old = xb_add(&bar[XB_XSUB(b.x)], 1u);
        const unsigned gen = old / nloc;
        if (old + 1u == (gen + 1u) * nloc) {
            __builtin_amdgcn_fence(__ATOMIC_RELEASE, "agent");
            asm volatile("s_waitcnt vmcnt(0)" ::: "memory");
            const unsigned og = xb_add(&bar[XB_TOP], 1u);
            const unsigned tg = og / nx;
            if (og + 1u == (tg + 1u) * nx) xb_add(&bar[XB_TOPGEN], 1u);
            else XB_SPIN(xb_ld(&bar[XB_TOPGEN]) == tg, bar);
            __builtin_amdgcn_fence(__ATOMIC_ACQUIRE, "agent");
            xb_add(&bar[XB_XGEN(b.x)], 1u);
            asm volatile("s_waitcnt vmcnt(0)" ::: "memory");
        } else {
            XB_SPIN(xb_ld(&bar[XB_XGEN(b.x)]) == gen, bar);
            __builtin_amdgcn_fence(__ATOMIC_ACQUIRE, "agent");
            asm volatile("s_waitcnt vmcnt(0)" ::: "memory");
        }
    }
    __syncthreads();
}

struct Frame {
    LAS unsigned char* lds;
    volatile LAS unsigned* MISC;
    gu32* ctl;
    int tid, lane, wave, G;
    const float* x; float* out;
    const float *rel_bias, *attn_pre, *attn_win, *attn_wout, *attn_post, *ssm_pre, *ssm_win, *a_re, *a_im, *log_dt, *b_re, *b_im, *c_re, *c_im, *dskip, *w_glu, *b_glu, *ssm_wout, *ssm_post;
    bf16 *Wt_in, *Wt_ao, *Wt_si, *Wt_glu, *Wt_so;
    bf16 *XN, *OG, *Qh, *Kh, *VTh, *SZh, *XN2, *UG, *SZ2, *GB, *Y2;
    float *H2, *H3, *small;
};

__device__ __forceinline__ void p0_transpose_item(const float* W, int K, int N, bf16* WT, LAS float* scr, int item, int lane) {
    const int nblk = N / 32, kb = item / nblk, nb = item % nblk, k0 = 64 * kb, n0 = 32 * nb;
#pragma unroll 8
    for (int i = 0; i < 32; ++i) { const int kk = 2 * i + (lane >> 5); scr[kk * 33 + (lane & 31)] = W[(size_t)(k0 + kk) * N + n0 + (lane & 31)]; }
    asm volatile("s_waitcnt lgkmcnt(0)" ::: "memory");
    const int c = lane & 7;
#pragma unroll
    for (int j = 0; j < 4; ++j) { const int n = (lane >> 3) + 8 * j; const LAS float* s = scr + (8 * c) * 33 + n;
        u32x4 o; o.x = pk2(s[0 * 33], s[1 * 33]); o.y = pk2(s[2 * 33], s[3 * 33]); o.z = pk2(s[4 * 33], s[5 * 33]); o.w = pk2(s[6 * 33], s[7 * 33]);
        *(GAS u32x4*)(WT + (size_t)(n0 + n) * K + k0 + 8 * c) = o; }
    asm volatile("s_waitcnt lgkmcnt(0)" ::: "memory");
}
__device__ __forceinline__ void rms_row_to_bf16(const float* xrow, const float* gain, bf16* orow, int lane) {
    const GAS f32x4* xr = (const GAS f32x4*)xrow + lane; const GAS f32x4* gr = (const GAS f32x4*)gain + lane;
    f32x4 v[4]; float s = 0.f;
#pragma unroll
    for (int j = 0; j < 4; ++j) { v[j] = xr[64 * j]; s += (v[j].x * v[j].x + v[j].y * v[j].y) + (v[j].z * v[j].z + v[j].w * v[j].w); }
    const float rs = 1.f / sqrtf(wave_sum(s) * (1.f / D) + EPS);
    GAS unsigned long long* o8 = (GAS unsigned long long*)orow + lane;
#pragma unroll
    for (int j = 0; j < 4; ++j) { const f32x4 g = gr[64 * j]; o8[64 * j] = (unsigned long long)pk2(v[j].x * rs * g.x, v[j].y * rs * g.y) | ((unsigned long long)pk2(v[j].z * rs * g.z, v[j].w * rs * g.w) << 32); }
}
__device__ __forceinline__ int t5_bucket(int dist) {
    const int n = dist < 1 ? 1 : dist;
    int large = 16 + (int)(logf((float)n / 16.f) / 4.852030263919617f * 16.f);
    large = large < 31 ? large : 31;
    return dist < 16 ? dist : large;
}
__device__ __forceinline__ void p0_prologue(Frame& F) {
    LAS float* scr = (LAS float*)(F.lds + F.wave * 16384);
    const int gw = blockIdx.x * 8 + F.wave, NGW = F.G * 8;
    constexpr int I_IN = (D / 64) * (NIN / 32), I_AO = (D / 64) * (D / 32), I_SI = (D / 64) * (2 * D / 32);
    constexpr int NITEMS = I_IN + I_AO + I_SI + I_AO + I_AO;
    for (int it = gw; it < NITEMS; it += NGW) {
        int r = it;
        if (r < I_IN) { p0_transpose_item(F.attn_win, D, NIN, F.Wt_in, scr, r, F.lane); continue; } r -= I_IN;
        if (r < I_AO) { p0_transpose_item(F.attn_wout, D, D, F.Wt_ao, scr, r, F.lane); continue; } r -= I_AO;
        if (r < I_SI) { p0_transpose_item(F.ssm_win, D, 2 * D, F.Wt_si, scr, r, F.lane); continue; } r -= I_SI;
        if (r < I_AO) { p0_transpose_item(F.w_glu, D, D, F.Wt_glu, scr, r, F.lane); continue; } r -= I_AO;
        p0_transpose_item(F.ssm_wout, D, D, F.Wt_so, scr, r, F.lane);
    }
    for (int m = gw; m < M; m += NGW) rms_row_to_bf16(F.x + (size_t)m * D, F.attn_pre, F.XN + (size_t)m * D, F.lane);
    const int gt = blockIdx.x * 512 + F.tid, NGT = F.G * 512;
    for (int i = gt; i < 64 * 64; i += NGT) {
        const int g = i >> 6;
        const float are = F.a_re[i], aim = F.a_im[i], dt = __expf(F.log_dt[g]);
        const float xr = are * dt, yi = aim * dt;
        float sn, cs; sincosf(yi, &sn, &cs);
        const float ex = expf(xr);
        F.small[SM_LAM + 2 * i] = ex * cs; F.small[SM_LAM + 2 * i + 1] = ex * sn;
        float sn16, cs16; sincosf(16.f * yi, &sn16, &cs16); const float ex16 = expf(16.f * xr);
        F.small[SM_LAMT + 2 * i] = ex16 * cs16; F.small[SM_LAMT + 2 * i + 1] = ex16 * sn16;
        const float sh = sinf(0.5f * yi);
        const float nr = expm1f(xr) * cs - 2.f * sh * sh, ni = ex * sn;
        const float den = are * are + aim * aim;
        const float fr = (nr * are + ni * aim) / den, fi = (ni * are - nr * aim) / den;
        for (int c = 0; c < 16; ++c) {
            const float br = F.b_re[i * 16 + c], bi = F.b_im[i * 16 + c];
            F.small[SM_BBAR + (i * 16 + c) * 2] = fr * br - fi * bi;
            F.small[SM_BBAR + (i * 16 + c) * 2 + 1] = fr * bi + fi * br;
        }
    }
    for (int i = gt; i < 3 * 16 * 192; i += NGT) {
        const int dist = i % 192, hh = (i / 192) & 15, g = i / (192 * 16);
        float v = -1e30f;
        if (dist <= 128) v = F.rel_bias[t5_bucket(dist << (2 * g)) * 16 + hh] * LOG2E;
        F.small[SM_BIAS + i] = v;
    }
}

template <class Epi> __device__ __forceinline__ void naive_gemm(Frame& F, const bf16* A, const bf16* Bt, int Mrows, int N, int K, const Epi& epi) {
    const int ntn = N / 32, nt = (Mrows / 32) * ntn;
    const int gw = blockIdx.x * 8 + F.wave, NGW = F.G * 8;
    const int r32 = F.lane & 31, hi = F.lane >> 5;
    for (int tile = gw; tile < nt; tile += NGW) {
        const int tm = tile / ntn, tn = tile % ntn;
        f32x16 acc = {};
        const bf16* ap = A + (size_t)(tm * 32 + r32) * K + hi * 8;
        const bf16* bp = Bt + (size_t)(tn * 32 + r32) * K + hi * 8;
#pragma unroll 4
        for (int k = 0; k < K; k += 16) {
            const bf16x8 a = *(const GAS bf16x8*)(ap + k); const bf16x8 b = *(const GAS bf16x8*)(bp + k);
            acc = __builtin_amdgcn_mfma_f32_32x32x16_bf16(a, b, acc, 0, 0, 0);
        }
#pragma unroll
        for (int r = 0; r < 16; ++r) epi(tm * 32 + (r & 3) + 8 * (r >> 2) + 4 * hi, tn * 32 + r32, acc[r]);
    }
}
struct EnInProj {
    bf16 *Qh, *Kh, *VTh, *SZh;
    __device__ __forceinline__ void operator()(int m, int n, float v) const {
        const int bl = m >> 11, t = m & 2047;
        if (n < 9216) {
            const int tq = n / 3072, rem = n % 3072, g = rem >> 10, hh = (rem >> 6) & 15, e = rem & 63, sh = 2 * g;
            const int row = (t & ((1 << sh) - 1)) * (2048 >> sh) + (t >> sh);
            const size_t hb = (size_t)((bl * 3 + g) * 16 + hh);
            if (tq == 0) Qh[(hb * 2048 + row) * 64 + e] = (bf16)f2bf(v * C2);
            else if (tq == 1) Kh[(hb * 2048 + row) * 64 + e] = (bf16)f2bf(v);
            else VTh[(hb * 64 + e) * 2048 + row] = (bf16)f2bf(v);
        } else SZh[(size_t)m * 1024 + (n - 9216)] = (bf16)f2bf(silu_f(v));
    }
};
struct EnF32 { float* out; __device__ __forceinline__ void operator()(int m, int n, float v) const { out[(size_t)m * 1024 + n] = v; } };
struct EnSsmIn {
    bf16 *UG, *SZ2;
    __device__ __forceinline__ void operator()(int m, int n, float v) const {
        if (n < 1024) { const int g = n >> 4, c = n & 15, b = m >> 11, t = m & 2047; UG[((size_t)(b * 64 + g) * 2048 + t) * 16 + c] = (bf16)f2bf(v); }
        else SZ2[(size_t)m * 1024 + (n - 1024)] = (bf16)f2bf(silu_f(v));
    }
};
struct EnGlu {
    const bf16 *GB, *SZ2; const float* bglu; bf16* Y2;
    __device__ __forceinline__ void operator()(int m, int n, float v) const {
        const size_t o = (size_t)m * 1024 + n; const float gv = bf2f(GB[o]);
        Y2[o] = (bf16)f2bf(gv * sigmoid_f(v + bglu[n]) * bf2f(SZ2[o]));
    }
};

__device__ __forceinline__ void naive_attn(Frame& F, int half) {
    const int gw = blockIdx.x * 8 + F.wave, NGW = F.G * 8, lane = F.lane;
    const float* bias = F.small + SM_BIAS;
    for (int it = gw; it < 4 * 2048 * 16; it += NGW) {
        const int hh = it & 15, t = (it >> 4) & 2047, bl = it >> 15;
        float og[3], lse[3];
#pragma unroll
        for (int g = 0; g < 3; ++g) {
            const int sh = 2 * g, L = 2048 >> sh, r_ = t & ((1 << sh) - 1), m_ = t >> sh;
            const size_t hb = (size_t)((bl * 3 + g) * 16 + hh);
            const size_t rowq = hb * 2048 + r_ * L + m_;
            const float qe = bf2f(F.Qh[rowq * 64 + lane]);
            float s0 = -INFINITY, s1 = -INFINITY, s2 = -INFINITY;
            const int jmax = m_ < 128 ? m_ : 128;
            const float* bt = bias + (g * 16 + hh) * 192;
            for (int j = 0; j <= jmax; ++j) {
                const float kv = bf2f(F.Kh[(rowq - j) * 64 + lane]);
                const float tot = wave_sum(qe * kv) + bt[j];
                if (j < 64) { if (lane == j) s0 = tot; } else if (j < 128) { if (lane == j - 64) s1 = tot; } else { if (lane == 0) s2 = tot; }
            }
            const float mx = wave_max(fmaxf(fmaxf(s0, s1), s2));
            const float p0 = exp2f(s0 - mx), p1 = exp2f(s1 - mx), p2 = exp2f(s2 - mx);
            const float sum = wave_sum(p0 + p1 + p2);
            float o = 0.f;
            const bf16* vp = F.VTh + (hb * 64 + lane) * 2048 + r_ * L + m_;
            for (int j = 0; j <= jmax; ++j) {
                const float pj = __shfl(j < 64 ? p0 : (j < 128 ? p1 : p2), j & 63);
                o += pj * bf2f(vp[-j]);
            }
            og[g] = o / sum; lse[g] = mx + log2f(sum);
        }
        const float mx = fmaxf(fmaxf(lse[0], lse[1]), lse[2]);
        const float w0 = exp2f(lse[0] - mx), w1 = exp2f(lse[1] - mx), w2 = exp2f(lse[2] - mx);
        const float o = (w0 * og[0] + w1 * og[1] + w2 * og[2]) / (w0 + w1 + w2);
        const size_t ml = (size_t)bl * 2048 + t;
        const float sz = bf2f(F.SZh[ml * 1024 + hh * 64 + lane]);
        F.OG[((size_t)half * HM + ml) * 1024 + hh * 64 + lane] = (bf16)f2bf(o * sz);
    }
}

__device__ __forceinline__ void naive_scan(Frame& F) {
    const int gw = blockIdx.x * 8 + F.wave, NGW = F.G * 8, lane = F.lane;
    for (int it = gw; it < 8 * 64; it += NGW) {
        const int g = it & 63, b = it >> 6;
        const int gp = g * 64 + lane;
        const float lr = F.small[SM_LAM + 2 * gp], li = F.small[SM_LAM + 2 * gp + 1];
        float xr = 0.f, xi = 0.f;
        const bf16* up = F.UG + (size_t)(b * 64 + g) * 2048 * 16;
        const float dsk = F.dskip[g * 16 + (lane & 15)];
        float bbr[16], bbi[16], ccr[16], cci[16];
#pragma unroll
        for (int c = 0; c < 16; ++c) { bbr[c] = F.small[SM_BBAR + (gp * 16 + c) * 2]; bbi[c] = F.small[SM_BBAR + (gp * 16 + c) * 2 + 1];
            ccr[c] = F.c_re[(g * 16 + c) * 64 + lane]; cci[c] = F.c_im[(g * 16 + c) * 64 + lane]; }
        for (int t = 0; t < 2048; ++t) {
            float bur = 0.f, bui = 0.f;
            float uown = 0.f;
#pragma unroll
            for (int c = 0; c < 16; ++c) {
                const float u = bf2f(up[t * 16 + c]);
                bur += bbr[c] * u; bui += bbi[c] * u;
                if ((lane & 15) == c) uown = u;
            }
            const float nr = lr * xr - li * xi + bur, ni = lr * xi + li * xr + bui;
            xr = nr; xi = ni;
            float yown = 0.f;
#pragma unroll
            for (int c = 0; c < 16; ++c) {
                const float v = ccr[c] * xr - cci[c] * xi;
                const float tot = wave_sum(v);
                if ((lane & 15) == c) yown = tot;
            }
            if (lane < 16) {
                const float y = yown + dsk * uown;
                F.GB[((size_t)b * 2048 + t) * 1024 + g * 16 + lane] = (bf16)f2bf(gelu_tanh_f(y));
            }
        }
    }
}

__device__ __forceinline__ void row_pass1(Frame& F) {
    const int gw = blockIdx.x * 8 + F.wave, NGW = F.G * 8, lane = F.lane;
    for (int m = gw; m < M; m += NGW) {
        const GAS f32x4* hr = (const GAS f32x4*)(F.H2 + (size_t)m * D) + lane; const GAS f32x4* xr = (const GAS f32x4*)(F.x + (size_t)m * D) + lane;
        const GAS f32x4* g1 = (const GAS f32x4*)F.attn_post + lane; const GAS f32x4* g2 = (const GAS f32x4*)F.ssm_pre + lane;
        f32x4 v[4]; float s = 0.f;
#pragma unroll
        for (int j = 0; j < 4; ++j) { v[j] = hr[64 * j]; s += (v[j].x * v[j].x + v[j].y * v[j].y) + (v[j].z * v[j].z + v[j].w * v[j].w); }
        const float rs = 1.f / sqrtf(wave_sum(s) * (1.f / D) + EPS);
        float s2 = 0.f;
#pragma unroll
        for (int j = 0; j < 4; ++j) { v[j] = xr[64 * j] + v[j] * rs * g1[64 * j]; s2 += (v[j].x * v[j].x + v[j].y * v[j].y) + (v[j].z * v[j].z + v[j].w * v[j].w); }
        const float rs2 = 1.f / sqrtf(wave_sum(s2) * (1.f / D) + EPS);
        GAS f32x4* o = (GAS f32x4*)(F.out + (size_t)m * D) + lane;
        GAS unsigned long long* o8 = (GAS unsigned long long*)(F.XN2 + (size_t)m * D) + lane;
#pragma unroll
        for (int j = 0; j < 4; ++j) { o[64 * j] = v[j]; const f32x4 g = g2[64 * j];
            o8[64 * j] = (unsigned long long)pk2(v[j].x * rs2 * g.x, v[j].y * rs2 * g.y) | ((unsigned long long)pk2(v[j].z * rs2 * g.z, v[j].w * rs2 * g.w) << 32); }
    }
}
__device__ __forceinline__ void row_pass2(Frame& F) {
    const int gw = blockIdx.x * 8 + F.wave, NGW = F.G * 8, lane = F.lane;
    for (int m = gw; m < M; m += NGW) {
        const GAS f32x4* hr = (const GAS f32x4*)(F.H3 + (size_t)m * D) + lane; GAS f32x4* o = (GAS f32x4*)(F.out + (size_t)m * D) + lane;
        const GAS f32x4* g1 = (const GAS f32x4*)F.ssm_post + lane;
        f32x4 v[4]; float s = 0.f;
#pragma unroll
        for (int j = 0; j < 4; ++j) { v[j] = hr[64 * j]; s += (v[j].x * v[j].x + v[j].y * v[j].y) + (v[j].z * v[j].z + v[j].w * v[j].w); }
        const float rs = 1.f / sqrtf(wave_sum(s) * (1.f / D) + EPS);
#pragma unroll
        for (int j = 0; j < 4; ++j) o[64 * j] = o[64 * j] + v[j] * rs * g1[64 * j];
    }
}

struct Args { const float* in[20]; float* out; unsigned char* ws; int ph_lo, ph_hi, li, pad; };
__global__ void __launch_bounds__(512, 2) mk_fwd(Args args) {
    extern __shared__ __attribute__((aligned(16))) unsigned char lds[];
    Frame F;
    F.lds = (LAS unsigned char*)lds;
    F.MISC = (volatile LAS unsigned*)(F.lds + MISC_OFF);
    F.tid = threadIdx.x; F.lane = F.tid & 63; F.wave = __builtin_amdgcn_readfirstlane(F.tid >> 6);
    F.G = gridDim.x;
    unsigned char* ws = args.ws;
    F.ctl = (gu32*)(ws + WS_CTL);
    F.x = args.in[0]; F.rel_bias = args.in[1]; F.attn_pre = args.in[2]; F.attn_win = args.in[3]; F.attn_wout = args.in[4]; F.attn_post = args.in[5];
    F.ssm_pre = args.in[6]; F.ssm_win = args.in[7]; F.a_re = args.in[8]; F.a_im = args.in[9]; F.log_dt = args.in[10]; F.b_re = args.in[11]; F.b_im = args.in[12];
    F.c_re = args.in[13]; F.c_im = args.in[14]; F.dskip = args.in[15]; F.w_glu = args.in[16]; F.b_glu = args.in[17]; F.ssm_wout = args.in[18]; F.ssm_post = args.in[19];
    F.out = args.out;
    F.Wt_in = (bf16*)(ws + WS_WT_IN); F.Wt_ao = (bf16*)(ws + WS_WT_AO); F.Wt_si = (bf16*)(ws + WS_WT_SI); F.Wt_glu = (bf16*)(ws + WS_WT_GLU); F.Wt_so = (bf16*)(ws + WS_WT_SO);
    F.XN = (bf16*)args.out;
    F.OG = (bf16*)(ws + WS_OG); F.Qh = (bf16*)(ws + WS_Q); F.Kh = (bf16*)(ws + WS_K); F.VTh = (bf16*)(ws + WS_VT); F.SZh = (bf16*)(ws + WS_SZ);
    F.XN2 = (bf16*)(ws + WS_XN2); F.UG = (bf16*)(ws + WS_UG); F.SZ2 = (bf16*)(ws + WS_SZ2); F.GB = (bf16*)(ws + WS_GB); F.Y2 = (bf16*)(ws + WS_Y2);
    F.H2 = (float*)(ws + WS_H2); F.H3 = (float*)(ws + WS_H3); F.small = (float*)(ws + WS_SMALL);
    for (int u = F.tid; u < (LDS_BYTES - LDSCTL_OFF) / 4; u += 512) ((LAS unsigned*)(F.lds + LDSCTL_OFF))[u] = 0u;
    __syncthreads();
    XcdBarrier bar; bar.bar = (unsigned*)(F.ctl + CW_BAR); bar.x = 0; bar.st = nullptr;
    if (N_LAUNCHES == 1) bar = xcd_barrier_post((unsigned*)(F.ctl + CW_BAR), F.MISC + 8);
    const int lo = args.ph_lo, hi = args.ph_hi;
#define IN(k) (lo <= (k) && (k) < hi)
#define SEAM(k) do { if (IN(k) && IN((k) + 1)) xcd_barrier(bar); } while (0)

    if (IN(0)) { p0_prologue(F); } SEAM(0);
    for (int half = 0; half < 2; ++half) {
        if (IN(1 + 2 * half)) { EnInProj E{F.Qh, F.Kh, F.VTh, F.SZh}; naive_gemm(F, F.XN + (size_t)half * HM * D, F.Wt_in, HM, NIN, D, E); } SEAM(1 + 2 * half);
        if (IN(2 + 2 * half)) { naive_attn(F, half); } SEAM(2 + 2 * half);
    }
    if (IN(5)) { EnF32 E{F.H2}; naive_gemm(F, F.OG, F.Wt_ao, M, D, D, E); } SEAM(5);
    if (IN(6)) { row_pass1(F); } SEAM(6);
    if (IN(7)) { EnSsmIn E{F.UG, F.SZ2}; naive_gemm(F, F.XN2, F.Wt_si, M, 2 * D, D, E); } SEAM(7);
    if (IN(8)) { naive_scan(F); } SEAM(8);
    if (IN(9)) { EnGlu E{F.GB, F.SZ2, F.b_glu, F.Y2}; naive_gemm(F, F.GB, F.Wt_glu, M, D, D, E); } SEAM(9);
    if (IN(10)) { EnF32 E{F.H3}; naive_gemm(F, F.Y2, F.Wt_so, M, D, D, E); } SEAM(10);
    if (IN(11)) { row_pass2(F); }
#undef IN
#undef SEAM
}

extern "C" void kernel_launch(void* const* d_in, const int* in_sizes, int n_in, void* d_out, int out_size, void* d_ws, size_t ws_size, hipStream_t stream) {
    static int grid = 0;
    if (grid == 0) {
        if (n_in != 20 || out_size != M * D || ws_size < WS_END) { fprintf(stderr, "kernel_launch: unexpected shapes n_in %d out %d ws %zu\n", n_in, out_size, ws_size); grid = -1; return; }
        int dev = 0, cus = 0, per_cu = 0;
        if (hipGetDevice(&dev) != hipSuccess || hipDeviceGetAttribute(&cus, hipDeviceAttributeMultiprocessorCount, dev) != hipSuccess) { grid = -1; return; }
        if (hipFuncSetAttribute((const void*)mk_fwd, hipFuncAttributeMaxDynamicSharedMemorySize, LDS_BYTES) != hipSuccess) { fprintf(stderr, "kernel_launch: hipFuncSetAttribute failed\n"); grid = -1; return; }
        if (hipOccupancyMaxActiveBlocksPerMultiprocessor(&per_cu, (const void*)mk_fwd, 512, LDS_BYTES) != hipSuccess || per_cu < 1) { fprintf(stderr, "kernel_launch: occupancy query says %d\n", per_cu); per_cu = 1; }
        (void)hipGetLastError();
        grid = cus;
    }
    if (grid < 0) return;
    (void)hipMemsetAsync((char*)d_ws + WS_CTL, 0, CTL_ZERO_BYTES, stream);
    Args a{};
    for (int i = 0; i < 20; ++i) a.in[i] = (const float*)d_in[i];
    a.out = (float*)d_out; a.ws = (unsigned char*)d_ws;
    for (int li = 0; li < N_LAUNCHES; ++li) {
        a.ph_lo = (N_LAUNCHES == 1) ? 0 : li; a.ph_hi = (N_LAUNCHES == 1) ? NPH : li + 1; a.li = li;
        hipLaunchKernelGGL(mk_fwd, dim3(grid), dim3(512), LDS_BYTES, stream, a);
    }
}
```

```cpp
#include <hip/hip_runtime.h>
#include <cstdio>
#include <cstdint>

#ifndef MK_N_LAUNCHES
#define MK_N_LAUNCHES 1
#endif

#define GAS __attribute__((address_space(1)))
#define LAS __attribute__((address_space(3)))
typedef unsigned short bf16;
typedef short bf16x8 __attribute__((ext_vector_type(8)));
typedef float f32x4 __attribute__((ext_vector_type(4)));
typedef float f32x16 __attribute__((ext_vector_type(16)));
typedef unsigned u32x4 __attribute__((ext_vector_type(4)));
typedef unsigned u32x2 __attribute__((ext_vector_type(2)));
typedef GAS unsigned gu32;

constexpr int BATCH = 8, SEQ = 2048, D = 1024, M = BATCH * SEQ;
constexpr int NIN = 10240;
constexpr int HM = M / 2;
constexpr int NPH = 12;
constexpr int N_LAUNCHES = MK_N_LAUNCHES;
constexpr float EPS = 1e-6f;
constexpr float LOG2E = 1.4426950408889634f;
constexpr float C2 = 0.125f * LOG2E;

constexpr size_t MiB = 1u << 20;
constexpr size_t WS_CTL = 0, CTL_ZERO_BYTES = 1 * MiB;
constexpr size_t WS_WT_IN = 2 * MiB, WS_WT_AO = 22 * MiB, WS_WT_SI = 24 * MiB, WS_WT_GLU = 28 * MiB, WS_WT_SO = 30 * MiB;
constexpr size_t WS_W1 = 32 * MiB, WS_WY = 36 * MiB;
constexpr size_t WS_SMALL = 48 * MiB;
constexpr size_t WS_OG = 49 * MiB;
constexpr size_t WS_Q = 81 * MiB, WS_K = 129 * MiB, WS_VT = 177 * MiB, WS_SZ = 225 * MiB;
constexpr size_t WS_H2 = 81 * MiB;
constexpr size_t WS_XN2 = 145 * MiB, WS_UG = 177 * MiB, WS_SZ2 = 209 * MiB;
constexpr size_t WS_GB = 81 * MiB, WS_Y2 = 113 * MiB, WS_H3 = 145 * MiB;
constexpr size_t WS_END = 256 * MiB;
constexpr int SM_LAM = 0;
constexpr int SM_LAMT = SM_LAM + 64 * 64 * 2;
constexpr int SM_BBAR = SM_LAMT + 64 * 64 * 2;
constexpr int SM_BIAS = SM_BBAR + 64 * 64 * 16 * 2;
constexpr int SM_END = SM_BIAS + 3 * 16 * 192;
static_assert((size_t)SM_END * 4 <= 1 * MiB, "small tables");
constexpr int CW_BAR = 4096;

constexpr int RING_BYTES = 131072;
constexpr int LDSCTL_OFF = RING_BYTES, MISC_OFF = LDSCTL_OFF + 320;
constexpr int LDS_BYTES = 147456;

#define RLX_AGENT __ATOMIC_RELAXED, __HIP_MEMORY_SCOPE_AGENT
__device__ __forceinline__ unsigned f2bf(float f) { unsigned u = __builtin_bit_cast(unsigned, f); return (u + 0x7fffu + ((u >> 16) & 1u)) >> 16; }
__device__ __forceinline__ unsigned pk2(float lo, float hi) { return f2bf(lo) | (f2bf(hi) << 16); }
__device__ __forceinline__ float bf2f(bf16 b) { return __builtin_bit_cast(float, ((unsigned)b) << 16); }
__device__ __forceinline__ float silu_f(float z) { return z / (1.f + __expf(-z)); }
__device__ __forceinline__ float sigmoid_f(float z) { return 1.f / (1.f + __expf(-z)); }
__device__ __forceinline__ float gelu_tanh_f(float x) { const float u = 0.7978845608028654f * (x + 0.044715f * x * x * x); const float t = 1.f - 2.f / (__expf(2.f * u) + 1.f); return 0.5f * x * (1.f + t); }
__device__ __forceinline__ float wave_sum(float v) {
#pragma unroll
    for (int o = 1; o < 64; o <<= 1) v += __shfl_xor(v, o);
    return v;
}
__device__ __forceinline__ float wave_max(float v) {
#pragma unroll
    for (int o = 1; o < 64; o <<= 1) v = fmaxf(v, __shfl_xor(v, o));
    return v;
}

#define XB_TMO      128
#define XB_XCNT(j)  (256  + 64 * (j))
#define XB_XSUB(j)  (1280 + 64 * (j))
#define XB_XGEN(j)  (2304 + 64 * (j))
#define XB_TOP      3328
#define XB_TOPGEN   3392
#define XCD_BAR_WORDS 3456
#define XB_SPIN_CAP (1u << 22)
__device__ __forceinline__ unsigned xb_ld(unsigned* p)              { return __hip_atomic_load(p, __ATOMIC_RELAXED, __HIP_MEMORY_SCOPE_AGENT); }
__device__ __forceinline__ unsigned xb_add(unsigned* p, unsigned v) { return __hip_atomic_fetch_add(p, v, __ATOMIC_RELAXED, __HIP_MEMORY_SCOPE_AGENT); }
__device__ __forceinline__ unsigned xb_xcc_id() { return (unsigned)__builtin_amdgcn_s_getreg((3 << 11) | 20) & 0xFu; }
#define XB_SPIN(cond, bar) do { unsigned _sp = 0; while (cond) { __builtin_amdgcn_s_sleep(1); \
    if ((++_sp & 255u) == 0u) { if (xb_ld(&(bar)[XB_TMO])) break; if (_sp > XB_SPIN_CAP) { atomicAdd(&(bar)[XB_TMO], 1u); break; } } } } while (0)
struct XcdBarrier { unsigned* bar; unsigned x; volatile LAS unsigned* st; };
__device__ __forceinline__ XcdBarrier xcd_barrier_post(unsigned* bar, volatile LAS unsigned* st) {
    XcdBarrier b; b.bar = bar; b.x = xb_xcc_id(); b.st = st;
    if (threadIdx.x == 0) (void)xb_add(&bar[XB_XCNT(b.x)], 1u);
    return b;
}
__device__ __forceinline__ void xcd_barrier_complete(unsigned* bar, unsigned x, unsigned& nloc, unsigned& nx) {
    const unsigned G = gridDim.x * gridDim.y * gridDim.z;
    unsigned sum, cnt, mine, sp = 0u;
    for (;;) {
        sum = 0u; cnt = 0u; mine = 0u;
#pragma unroll
        for (unsigned j = 0; j < 16; ++j) { const unsigned c = xb_ld(&bar[XB_XCNT(j)]); sum += c; cnt += (c > 0u) ? 1u : 0u; mine = (j == x) ? c : mine; }
        if (sum == G) break;
        __builtin_amdgcn_s_sleep(1);
        if ((++sp & 255u) == 0u) { if (xb_ld(&bar[XB_TMO])) break; if (sp > XB_SPIN_CAP) { atomicAdd(&bar[XB_TMO], 1u); break; } }
    }
    nloc = mine > 0u ? mine : 1u; nx = cnt > 0u ? cnt : 1u;
}
__device__ __forceinline__ void xcd_barrier(const XcdBarrier& b) {
    asm volatile("s_waitcnt vmcnt(0)" ::: "memory");
    __syncthreads();
    if (threadIdx.x == 0) {
        unsigned* bar = b.bar;
        __builtin_amdgcn_s_waitcnt(0);
        unsigned nloc = b.st[0], nx = b.st[1];
        if (nloc == 0u) { xcd_barrier_complete(bar, b.x, nloc, nx); b.st[0] = nloc; b.st[1] = nx; }
        const unsigned old = xb_add(&bar[XB_XSUB(b.x)], 1u);
        const unsigned gen = old / nloc;
        if (old + 1u == (gen + 1u) * nloc) {
            __builtin_amdgcn_fence(__ATOMIC_RELEASE, "agent");
            asm volatile("s_waitcnt vmcnt(0)" ::: "memory");
            const unsigned og = xb_add(&bar[XB_TOP], 1u);
            const unsigned tg = og / nx;
            if (og + 1u == (tg + 1u) * nx) xb_add(&bar[XB_TOPGEN], 1u);
            else XB_SPIN(xb_ld(&bar[XB_TOPGEN]) == tg, bar);
            __builtin_amdgcn_fence(__ATOMIC_ACQUIRE, "agent");
            xb_add(&bar[XB_XGEN(b.x)], 1u);
            asm volatile("s_waitcnt vmcnt(0)" ::: "memory");
        } else {
            XB_SPIN(xb_ld(&bar[XB_XGEN(b.x)]) == gen, bar);
            __builtin_amdgcn_fence(__ATOMIC_ACQUIRE, "agent");
            asm volatile("s_waitcnt vmcnt(0)" ::: "memory");
        }
    }
    __syncthreads();
}

struct Frame {
    LAS unsigned char* lds;
    volatile LAS unsigned* MISC;
    gu32* ctl;
    int tid, lane, wave, G;
    const float* x; float* out;
    const float *rel_bias, *attn_pre, *attn_win, *attn_wout, *attn_post, *ssm_pre, *ssm_win, *a_re, *a_im, *log_dt, *b_re, *b_im, *c_re, *c_im, *dskip, *w_glu, *b_glu, *ssm_wout, *ssm_post;
    bf16 *Wt_in, *Wt_ao, *Wt_si, *Wt_glu, *Wt_so;
    bf16 *XN, *OG, *Qh, *Kh, *VTh, *SZh, *XN2, *UG, *SZ2, *GB, *Y2;
    float *H2, *H3, *small;
};

__device__ __forceinline__ void p0_transpose_item(const float* W, int K, int N, bf16* WT, LAS float* scr, int item, int lane) {
    const int nblk = N / 32, kb = item / nblk, nb = item % nblk, k0 = 64 * kb, n0 = 32 * nb;
#pragma unroll 8
    for (int i = 0; i < 32; ++i) { const int kk = 2 * i + (lane >> 5); scr[kk * 33 + (lane & 31)] = W[(size_t)(k0 + kk) * N + n0 + (lane & 31)]; }
    asm volatile("s_waitcnt lgkmcnt(0)" ::: "memory");
    const int c = lane & 7;
#pragma unroll
    for (int j = 0; j < 4; ++j) { const int n = (lane >> 3) + 8 * j; const LAS float* s = scr + (8 * c) * 33 + n;
        u32x4 o; o.x = pk2(s[0 * 33], s[1 * 33]); o.y = pk2(s[2 * 33], s[3 * 33]); o.z = pk2(s[4 * 33], s[5 * 33]); o.w = pk2(s[6 * 33], s[7 * 33]);
        *(GAS u32x4*)(WT + (size_t)(n0 + n) * K + k0 + 8 * c) = o; }
    asm volatile("s_waitcnt lgkmcnt(0)" ::: "memory");
}
__device__ __forceinline__ void rms_row_to_bf16(const float* xrow, const float* gain, bf16* orow, int lane) {
    const GAS f32x4* xr = (const GAS f32x4*)xrow + lane; const GAS f32x4* gr = (const GAS f32x4*)gain + lane;
    f32x4 v[4]; float s = 0.f;
#pragma unroll
    for (int j = 0; j < 4; ++j) { v[j] = xr[64 * j]; s += (v[j].x * v[j].x + v[j].y * v[j].y) + (v[j].z * v[j].z + v[j].w * v[j].w); }
    const float rs = 1.f / sqrtf(wave_sum(s) * (1.f / D) + EPS);
    GAS unsigned long long* o8 = (GAS unsigned long long*)orow + lane;
#pragma unroll
    for (int j = 0; j < 4; ++j) { const f32x4 g = gr[64 * j]; o8[64 * j] = (unsigned long long)pk2(v[j].x * rs * g.x, v[j].y * rs * g.y) | ((unsigned long long)pk2(v[j].z * rs * g.z, v[j].w * rs * g.w) << 32); }
}
__device__ __forceinline__ int t5_bucket(int dist) {
    const int n = dist < 1 ? 1 : dist;
    int large = 16 + (int)(logf((float)n / 16.f) / 4.852030263919617f * 16.f);
    large = large < 31 ? large : 31;
    return dist < 16 ? dist : large;
}
__device__ __forceinline__ void p0_prologue(Frame& F) {
    LAS float* scr = (LAS float*)(F.lds + F.wave * 16384);
    const int gw = blockIdx.x * 8 + F.wave, NGW = F.G * 8;
    constexpr int I_IN = (D / 64) * (NIN / 32), I_AO = (D / 64) * (D / 32), I_SI = (D / 64) * (2 * D / 32);
    constexpr int NITEMS = I_IN + I_AO + I_SI + I_AO + I_AO;
    for (int it = gw; it < NITEMS; it += NGW) {
        int r = it;
        if (r < I_IN) { p0_transpose_item(F.attn_win, D, NIN, F.Wt_in, scr, r, F.lane); continue; } r -= I_IN;
        if (r < I_AO) { p0_transpose_item(F.attn_wout, D, D, F.Wt_ao, scr, r, F.lane); continue; } r -= I_AO;
        if (r < I_SI) { p0_transpose_item(F.ssm_win, D, 2 * D, F.Wt_si, scr, r, F.lane); continue; } r -= I_SI;
        if (r < I_AO) { p0_transpose_item(F.w_glu, D, D, F.Wt_glu, scr, r, F.lane); continue; } r -= I_AO;
        p0_transpose_item(F.ssm_wout, D, D, F.Wt_so, scr, r, F.lane);
    }
    for (int m = gw; m < M; m += NGW) rms_row_to_bf16(F.x + (size_t)m * D, F.attn_pre, F.XN + (size_t)m * D, F.lane);
    const int gt = blockIdx.x * 512 + F.tid, NGT = F.G * 512;
    for (int i = gt; i < 64 * 64; i += NGT) {
        const int g = i >> 6;
        const float are = F.a_re[i], aim = F.a_im[i], dt = __expf(F.log_dt[g]);
        const float xr = are * dt, yi = aim * dt;
        float sn, cs; sincosf(yi, &sn, &cs);
        const float ex = expf(xr);
        F.small[SM_LAM + 2 * i] = ex * cs; F.small[SM_LAM + 2 * i + 1] = ex * sn;
        float sn16, cs16; sincosf(16.f * yi, &sn16, &cs16); const float ex16 = expf(16.f * xr);
        F.small[SM_LAMT + 2 * i] = ex16 * cs16; F.small[SM_LAMT + 2 * i + 1] = ex16 * sn16;
        const float sh = sinf(0.5f * yi);
        const float nr = expm1f(xr) * cs - 2.f * sh * sh, ni = ex * sn;
        const float den = are * are + aim * aim;
        const float fr = (nr * are + ni * aim) / den, fi = (ni * are - nr * aim) / den;
        for (int c = 0; c < 16; ++c) {
            const float br = F.b_re[i * 16 + c], bi = F.b_im[i * 16 + c];
            F.small[SM_BBAR + (i * 16 + c) * 2] = fr * br - fi * bi;
            F.small[SM_BBAR + (i * 16 + c) * 2 + 1] = fr * bi + fi * br;
        }
    }
    for (int i = gt; i < 3 * 16 * 192; i += NGT) {
        const int dist = i % 192, hh = (i / 192) & 15, g = i / (192 * 16);
        float v = -1e30f;
        if (dist <= 128) v = F.rel_bias[t5_bucket(dist << (2 * g)) * 16 + hh] * LOG2E;
        F.small[SM_BIAS + i] = v;
    }
}

template <class Epi> __device__ __forceinline__ void naive_gemm(Frame& F, const bf16* A, const bf16* Bt, int Mrows, int N, int K, const Epi& epi) {
    const int ntn = N / 32, nt = (Mrows / 32) * ntn;
    const int gw = blockIdx.x * 8 + F.wave, NGW = F.G * 8;
    const int r32 = F.lane & 31, hi = F.lane >> 5;
    for (int tile = gw; tile < nt; tile += NGW) {
        const int tm = tile / ntn, tn = tile % ntn;
        f32x16 acc = {};
        const bf16* ap = A + (size_t)(tm * 32 + r32) * K + hi * 8;
        const bf16* bp = Bt + (size_t)(tn * 32 + r32) * K + hi * 8;
#pragma unroll 4
        for (int k = 0; k < K; k += 16) {
            const bf16x8 a = *(const GAS bf16x8*)(ap + k); const bf16x8 b = *(const GAS bf16x8*)(bp + k);
            acc = __builtin_amdgcn_mfma_f32_32x32x16_bf16(a, b, acc, 0, 0, 0);
        }
#pragma unroll
        for (int r = 0; r < 16; ++r) epi(tm * 32 + (r & 3) + 8 * (r >> 2) + 4 * hi, tn * 32 + r32, acc[r]);
    }
}
struct EnInProj {
    bf16 *Qh, *Kh, *VTh, *SZh;
    __device__ __forceinline__ void operator()(int m, int n, float v) const {
        const int bl = m >> 11, t = m & 2047;
        if (n < 9216) {
            const int tq = n / 3072, rem = n % 3072, g = rem >> 10, hh = (rem >> 6) & 15, e = rem & 63, sh = 2 * g;
            const int row = (t & ((1 << sh) - 1)) * (2048 >> sh) + (t >> sh);
            const size_t hb = (size_t)((bl * 3 + g) * 16 + hh);
            if (tq == 0) Qh[(hb * 2048 + row) * 64 + e] = (bf16)f2bf(v * C2);
            else if (tq == 1) Kh[(hb * 2048 + row) * 64 + e] = (bf16)f2bf(v);
            else VTh[(hb * 64 + e) * 2048 + row] = (bf16)f2bf(v);
        } else SZh[(size_t)m * 1024 + (n - 9216)] = (bf16)f2bf(silu_f(v));
    }
};
struct EnF32 { float* out; __device__ __forceinline__ void operator()(int m, int n, float v) const { out[(size_t)m * 1024 + n] = v; } };
struct EnSsmIn {
    bf16 *UG, *SZ2;
    __device__ __forceinline__ void operator()(int m, int n, float v) const {
        if (n < 1024) { const int g = n >> 4, c = n & 15, b = m >> 11, t = m & 2047; UG[((size_t)(b * 64 + g) * 2048 + t) * 16 + c] = (bf16)f2bf(v); }
        else SZ2[(size_t)m * 1024 + (n - 1024)] = (bf16)f2bf(silu_f(v));
    }
};
struct EnGlu {
    const bf16 *GB, *SZ2; const float* bglu; bf16* Y2;
    __device__ __forceinline__ void operator()(int m, int n, float v) const {
        const size_t o = (size_t)m * 1024 + n; const float gv = bf2f(GB[o]);
        Y2[o] = (bf16)f2bf(gv * sigmoid_f(v + bglu[n]) * bf2f(SZ2[o]));
    }
};

__device__ __forceinline__ void naive_attn(Frame& F, int half) {
    const int gw = blockIdx.x * 8 + F.wave, NGW = F.G * 8, lane = F.lane;
    const float* bias = F.small + SM_BIAS;
    for (int it = gw; it < 4 * 2048 * 16; it += NGW) {
        const int hh = it & 15, t = (it >> 4) & 2047, bl = it >> 15;
        float og[3], lse[3];
#pragma unroll
        for (int g = 0; g < 3; ++g) {
            const int sh = 2 * g, L = 2048 >> sh, r_ = t & ((1 << sh) - 1), m_ = t >> sh;
            const size_t hb = (size_t)((bl * 3 + g) * 16 + hh);
            const size_t rowq = hb * 2048 + r_ * L + m_;
            const float qe = bf2f(F.Qh[rowq * 64 + lane]);
            float s0 = -INFINITY, s1 = -INFINITY, s2 = -INFINITY;
            const int jmax = m_ < 128 ? m_ : 128;
            const float* bt = bias + (g * 16 + hh) * 192;
            for (int j = 0; j <= jmax; ++j) {
                const float kv = bf2f(F.Kh[(rowq - j) * 64 + lane]);
                const float tot = wave_sum(qe * kv) + bt[j];
                if (j < 64) { if (lane == j) s0 = tot; } else if (j < 128) { if (lane == j - 64) s1 = tot; } else { if (lane == 0) s2 = tot; }
            }
            const float mx = wave_max(fmaxf(fmaxf(s0, s1), s2));
            const float p0 = exp2f(s0 - mx), p1 = exp2f(s1 - mx), p2 = exp2f(s2 - mx);
            const float sum = wave_sum(p0 + p1 + p2);
            float o = 0.f;
            const bf16* vp = F.VTh + (hb * 64 + lane) * 2048 + r_ * L + m_;
            for (int j = 0; j <= jmax; ++j) {
                const float pj = __shfl(j < 64 ? p0 : (j < 128 ? p1 : p2), j & 63);
                o += pj * bf2f(vp[-j]);
            }
            og[g] = o / sum; lse[g] = mx + log2f(sum);
        }
        const float mx = fmaxf(fmaxf(lse[0], lse[1]), lse[2]);
        const float w0 = exp2f(lse[0] - mx), w1 = exp2f(lse[1] - mx), w2 = exp2f(lse[2] - mx);
        const float o = (w0 * og[0] + w1 * og[1] + w2 * og[2]) / (w0 + w1 + w2);
        const size_t ml = (size_t)bl * 2048 + t;
        const float sz = bf2f(F.SZh[ml * 1024 + hh * 64 + lane]);
        F.OG[((size_t)half * HM + ml) * 1024 + hh * 64 + lane] = (bf16)f2bf(o * sz);
    }
}

__device__ __forceinline__ void naive_scan(Frame& F) {
    const int gw = blockIdx.x * 8 + F.wave, NGW = F.G * 8, lane = F.lane;
    for (int it = gw; it < 8 * 64; it += NGW) {
        const int g = it & 63, b = it >> 6;
        const int gp = g * 64 + lane;
        const float lr = F.small[SM_LAM + 2 * gp], li = F.small[SM_LAM + 2 * gp + 1];
        float xr = 0.f, xi = 0.f;
        const bf16* up = F.UG + (size_t)(b * 64 + g) * 2048 * 16;
        const float dsk = F.dskip[g * 16 + (lane & 15)];
        float bbr[16], bbi[16], ccr[16], cci[16];
#pragma unroll
        for (int c = 0; c < 16; ++c) { bbr[c] = F.small[SM_BBAR + (gp * 16 + c) * 2]; bbi[c] = F.small[SM_BBAR + (gp * 16 + c) * 2 + 1];
            ccr[c] = F.c_re[(g * 16 + c) * 64 + lane]; cci[c] = F.c_im[(g * 16 + c) * 64 + lane]; }
        for (int t = 0; t < 2048; ++t) {
            float bur = 0.f, bui = 0.f;
            float uown = 0.f;
#pragma unroll
            for (int c = 0; c < 16; ++c) {
                const float u = bf2f(up[t * 16 + c]);
                bur += bbr[c] * u; bui += bbi[c] * u;
                if ((lane & 15) == c) uown = u;
            }
            const float nr = lr * xr - li * xi + bur, ni = lr * xi + li * xr + bui;
            xr = nr; xi = ni;
            float yown = 0.f;
#pragma unroll
            for (int c = 0; c < 16; ++c) {
                const float v = ccr[c] * xr - cci[c] * xi;
                const float tot = wave_sum(v);
                if ((lane & 15) == c) yown = tot;
            }
            if (lane < 16) {
                const float y = yown + dsk * uown;
                F.GB[((size_t)b * 2048 + t) * 1024 + g * 16 + lane] = (bf16)f2bf(gelu_tanh_f(y));
            }
        }
    }
}

__device__ __forceinline__ void row_pass1(Frame& F) {
    const int gw = blockIdx.x * 8 + F.wave, NGW = F.G * 8, lane = F.lane;
    for (int m = gw; m < M; m += NGW) {
        const GAS f32x4* hr = (const GAS f32x4*)(F.H2 + (size_t)m * D) + lane; const GAS f32x4* xr = (const GAS f32x4*)(F.x + (size_t)m * D) + lane;
        const GAS f32x4* g1 = (const GAS f32x4*)F.attn_post + lane; const GAS f32x4* g2 = (const GAS f32x4*)F.ssm_pre + lane;
        f32x4 v[4]; float s = 0.f;
#pragma unroll
        for (int j = 0; j < 4; ++j) { v[j] = hr[64 * j]; s += (v[j].x * v[j].x + v[j].y * v[j].y) + (v[j].z * v[j].z + v[j].w * v[j].w); }
        const float rs = 1.f / sqrtf(wave_sum(s) * (1.f / D) + EPS);
        float s2 = 0.f;
#pragma unroll
        for (int j = 0; j < 4; ++j) { v[j] = xr[64 * j] + v[j] * rs * g1[64 * j]; s2 += (v[j].x * v[j].x + v[j].y * v[j].y) + (v[j].z * v[j].z + v[j].w * v[j].w); }
        const float rs2 = 1.f / sqrtf(wave_sum(s2) * (1.f / D) + EPS);
        GAS f32x4* o = (GAS f32x4*)(F.out + (size_t)m * D) + lane;
        GAS unsigned long long* o8 = (GAS unsigned long long*)(F.XN2 + (size_t)m * D) + lane;
#pragma unroll
        for (int j = 0; j < 4; ++j) { o[64 * j] = v[j]; const f32x4 g = g2[64 * j];
            o8[64 * j] = (unsigned long long)pk2(v[j].x * rs2 * g.x, v[j].y * rs2 * g.y) | ((unsigned long long)pk2(v[j].z * rs2 * g.z, v[j].w * rs2 * g.w) << 32); }
    }
}
__device__ __forceinline__ void row_pass2(Frame& F) {
    const int gw = blockIdx.x * 8 + F.wave, NGW = F.G * 8, lane = F.lane;
    for (int m = gw; m < M; m += NGW) {
        const GAS f32x4* hr = (const GAS f32x4*)(F.H3 + (size_t)m * D) + lane; GAS f32x4* o = (GAS f32x4*)(F.out + (size_t)m * D) + lane;
        const GAS f32x4* g1 = (const GAS f32x4*)F.ssm_post + lane;
        f32x4 v[4]; float s = 0.f;
#pragma unroll
        for (int j = 0; j < 4; ++j) { v[j] = hr[64 * j]; s += (v[j].x * v[j].x + v[j].y * v[j].y) + (v[j].z * v[j].z + v[j].w * v[j].w); }
        const float rs = 1.f / sqrtf(wave_sum(s) * (1.f / D) + EPS);
#pragma unroll
        for (int j = 0; j < 4; ++j) o[64 * j] = o[64 * j] + v[j] * rs * g1[64 * j];
    }
}

struct Args { const float* in[20]; float* out; unsigned char* ws; int ph_lo, ph_hi, li, pad; };
__global__ void __launch_bounds__(512, 2) mk_fwd(Args args) {
    extern __shared__ __attribute__((aligned(16))) unsigned char lds[];
    Frame F;
    F.lds = (LAS unsigned char*)lds;
    F.MISC = (volatile LAS unsigned*)(F.lds + MISC_OFF);
    F.tid = threadIdx.x; F.lane = F.tid & 63; F.wave = __builtin_amdgcn_readfirstlane(F.tid >> 6);
    F.G = gridDim.x;
    unsigned char* ws = args.ws;
    F.ctl = (gu32*)(ws + WS_CTL);
    F.x = args.in[0]; F.rel_bias = args.in[1]; F.attn_pre = args.in[2]; F.attn_win = args.in[3]; F.attn_wout = args.in[4]; F.attn_post = args.in[5];
    F.ssm_pre = args.in[6]; F.ssm_win = args.in[7]; F.a_re = args.in[8]; F.a_im = args.in[9]; F.log_dt = args.in[10]; F.b_re = args.in[11]; F.b_im = args.in[12];
    F.c_re = args.in[13]; F.c_im = args.in[14]; F.dskip = args.in[15]; F.w_glu = args.in[16]; F.b_glu = args.in[17]; F.ssm_wout = args.in[18]; F.ssm_post = args.in[19];
    F.out = args.out;
    F.Wt_in = (bf16*)(ws + WS_WT_IN); F.Wt_ao = (bf16*)(ws + WS_WT_AO); F.Wt_si = (bf16*)(ws + WS_WT_SI); F.Wt_glu = (bf16*)(ws + WS_WT_GLU); F.Wt_so = (bf16*)(ws + WS_WT_SO);
    F.XN = (bf16*)args.out;
    F.OG = (bf16*)(ws + WS_OG); F.Qh = (bf16*)(ws + WS_Q); F.Kh = (bf16*)(ws + WS_K); F.VTh = (bf16*)(ws + WS_VT); F.SZh = (bf16*)(ws + WS_SZ);
    F.XN2 = (bf16*)(ws + WS_XN2); F.UG = (bf16*)(ws + WS_UG); F.SZ2 = (bf16*)(ws + WS_SZ2); F.GB = (bf16*)(ws + WS_GB); F.Y2 = (bf16*)(ws + WS_Y2);
    F.H2 = (float*)(ws + WS_H2); F.H3 = (float*)(ws + WS_H3); F.small = (float*)(ws + WS_SMALL);
    for (int u = F.tid; u < (LDS_BYTES - LDSCTL_OFF) / 4; u += 512) ((LAS unsigned*)(F.lds + LDSCTL_OFF))[u] = 0u;
    __syncthreads();
    XcdBarrier bar; bar.bar = (unsigned*)(F.ctl + CW_BAR); bar.x = 0; bar.st = nullptr;
    if (N_LAUNCHES == 1) bar = xcd_barrier_post((unsigned*)(F.ctl + CW_BAR), F.MISC + 8);
    const int lo = args.ph_lo, hi = args.ph_hi;
#define IN(k) (lo <= (k) && (k) < hi)
#define SEAM(k) do { if (IN(k) && IN((k) + 1)) xcd_barrier(bar); } while (0)

    if (IN(0)) { p0_prologue(F); } SEAM(0);
    for (int half = 0; half < 2; ++half) {
        if (IN(1 + 2 * half)) { EnInProj E{F.Qh, F.Kh, F.VTh, F.SZh}; naive_gemm(F, F.XN + (size_t)half * HM * D, F.Wt_in, HM, NIN, D, E); } SEAM(1 + 2 * half);
        if (IN(2 + 2 * half)) { naive_attn(F, half); } SEAM(2 + 2 * half);
    }
    if (IN(5)) { EnF32 E{F.H2}; naive_gemm(F, F.OG, F.Wt_ao, M, D, D, E); } SEAM(5);
    if (IN(6)) { row_pass1(F); } SEAM(6);
    if (IN(7)) { EnSsmIn E{F.UG, F.SZ2}; naive_gemm(F, F.XN2, F.Wt_si, M, 2 * D, D, E); } SEAM(7);
    if (IN(8)) { naive_scan(F); } SEAM(8);
    if (IN(9)) { EnGlu E{F.GB, F.SZ2, F.b_glu, F.Y2}; naive_gemm(F, F.GB, F.Wt_glu, M, D, D, E); } SEAM(9);
    if (IN(10)) { EnF32 E{F.H3}; naive_gemm(F, F.Y2, F.Wt_so, M, D, D, E); } SEAM(10);
    if (IN(11)) { row_pass2(F); }
#undef IN
#undef SEAM
}

extern "C" void kernel_launch(void* const* d_in, const int* in_sizes, int n_in, void* d_out, int out_size, void* d_ws, size_t ws_size, hipStream_t stream) {
    static int grid = 0;
    if (grid == 0) {
        if (n_in != 20 || out_size != M * D || ws_size < WS_END) { fprintf(stderr, "kernel_launch: unexpected shapes n_in %d out %d ws %zu\n", n_in, out_size, ws_size); grid = -1; return; }
        int dev = 0, cus = 0, per_cu = 0;
        if (hipGetDevice(&dev) != hipSuccess || hipDeviceGetAttribute(&cus, hipDeviceAttributeMultiprocessorCount, dev) != hipSuccess) { grid = -1; return; }
        if (hipFuncSetAttribute((const void*)mk_fwd, hipFuncAttributeMaxDynamicSharedMemorySize, LDS_BYTES) != hipSuccess) { fprintf(stderr, "kernel_launch: hipFuncSetAttribute failed\n"); grid = -1; return; }
        if (hipOccupancyMaxActiveBlocksPerMultiprocessor(&per_cu, (const void*)mk_fwd, 512, LDS_BYTES) != hipSuccess || per_cu < 1) { fprintf(stderr, "kernel_launch: occupancy query says %d\n", per_cu); per_cu = 1; }
        (void)hipGetLastError();
        grid = cus;
    }
    if (grid < 0) return;
    (void)hipMemsetAsync((char*)d_ws + WS_CTL, 0, CTL_ZERO_BYTES, stream);
    Args a{};
    for (int i = 0; i < 20; ++i) a.in[i] = (const float*)d_in[i];
    a.out = (float*)d_out; a.ws = (unsigned char*)d_ws;
    for (int li = 0; li < N_LAUNCHES; ++li) {
        a.ph_lo = (N_LAUNCHES == 1) ? 0 : li; a.ph_hi = (N_LAUNCHES == 1) ? NPH : li + 1; a.li = li;
        hipLaunchKernelGGL(mk_fwd, dim3(grid), dim3(512), LDS_BYTES, stream, a);
    }
}
```

```cpp
#include <hip/hip_runtime.h>
#include <cstdio>
#include <cstdint>

#ifndef MK_N_LAUNCHES
#define MK_N_LAUNCHES 1
#endif
#define OPT_GEMM_IN 1
#define OPT_GEMM_AO 1
#define OPT_GEMM_SI 1
#define OPT_GEMM_GLU 1
#define OPT_GEMM_SO 1
#define OPT_ATTN 1

#define GAS __attribute__((address_space(1)))
#define LAS __attribute__((address_space(3)))
typedef unsigned short bf16;
typedef short bf16x8 __attribute__((ext_vector_type(8)));
typedef float f32x4 __attribute__((ext_vector_type(4)));
typedef float f32x16 __attribute__((ext_vector_type(16)));
typedef unsigned u32x4 __attribute__((ext_vector_type(4)));
typedef unsigned u32x2 __attribute__((ext_vector_type(2)));
typedef GAS unsigned gu32;

constexpr int BATCH = 8, SEQ = 2048, D = 1024, M = BATCH * SEQ;
constexpr int NIN = 10240;
constexpr int HM = M / 2;
constexpr int NPH = 12;
constexpr int N_LAUNCHES = MK_N_LAUNCHES;
constexpr float EPS = 1e-6f;
constexpr float LOG2E = 1.4426950408889634f;
constexpr float C2 = 0.125f * LOG2E;

constexpr size_t MiB = 1u << 20;
constexpr size_t WS_CTL = 0, CTL_ZERO_BYTES = 1 * MiB;
constexpr size_t WS_WT_IN = 2 * MiB, WS_WT_AO = 22 * MiB, WS_WT_SI = 24 * MiB, WS_WT_GLU = 28 * MiB, WS_WT_SO = 30 * MiB;
constexpr size_t WS_W1 = 32 * MiB, WS_WY = 36 * MiB;
constexpr size_t WS_SMALL = 48 * MiB;
constexpr size_t WS_OG = 49 * MiB;
constexpr size_t WS_Q = 81 * MiB, WS_K = 129 * MiB, WS_VT = 177 * MiB, WS_SZ = 225 * MiB;
constexpr size_t WS_H2 = 81 * MiB;
constexpr size_t WS_XN2 = 145 * MiB, WS_UG = 177 * MiB, WS_SZ2 = 209 * MiB;
constexpr size_t WS_GB = 81 * MiB, WS_Y2 = 113 * MiB, WS_H3 = 145 * MiB;
constexpr size_t WS_END = 256 * MiB;
constexpr int SM_LAM = 0;
constexpr int SM_LAMT = SM_LAM + 64 * 64 * 2;
constexpr int SM_BBAR = SM_LAMT + 64 * 64 * 2;
constexpr int SM_BIAS = SM_BBAR + 64 * 64 * 16 * 2;
constexpr int SM_END = SM_BIAS + 3 * 16 * 192;
static_assert((size_t)SM_END * 4 <= 1 * MiB, "small tables");
constexpr int CW_BAR = 4096;

constexpr int RING_BYTES = 131072;
constexpr int LDSCTL_OFF = 139264, MISC_OFF = LDSCTL_OFF + 320;
constexpr int LDS_BYTES = 147456;

#define RLX_AGENT __ATOMIC_RELAXED, __HIP_MEMORY_SCOPE_AGENT
__device__ __forceinline__ int lane_id() { int l = (int)__builtin_amdgcn_mbcnt_hi(~0u, __builtin_amdgcn_mbcnt_lo(~0u, 0u)); asm volatile("" : "+v"(l)); return l; }
__device__ __forceinline__ unsigned f2bf(float f) { unsigned u = __builtin_bit_cast(unsigned, f); return (u + 0x7fffu + ((u >> 16) & 1u)) >> 16; }
__device__ __forceinline__ unsigned pk2(float lo, float hi) { return f2bf(lo) | (f2bf(hi) << 16); }
__device__ __forceinline__ float bf2f(bf16 b) { return __builtin_bit_cast(float, ((unsigned)b) << 16); }
__device__ __forceinline__ float silu_f(float z) { return z / (1.f + __expf(-z)); }
__device__ __forceinline__ float sigmoid_f(float z) { return 1.f / (1.f + __expf(-z)); }
__device__ __forceinline__ float gelu_tanh_f(float x) { const float u = 0.7978845608028654f * (x + 0.044715f * x * x * x); const float t = 1.f - 2.f / (__expf(2.f * u) + 1.f); return 0.5f * x * (1.f + t); }
__device__ __forceinline__ float wave_sum(float v) {
#pragma unroll
    for (int o = 1; o < 64; o <<= 1) v += __shfl_xor(v, o);
    return v;
}
__device__ __forceinline__ float wave_max(float v) {
#pragma unroll
    for (int o = 1; o < 64; o <<= 1) v = fmaxf(v, __shfl_xor(v, o));
    return v;
}

#define XB_TMO      128
#define XB_XCNT(j)  (256  + 64 * (j))
#define XB_XSUB(j)  (1280 + 64 * (j))
#define XB_XGEN(j)  (2304 + 64 * (j))
#define XB_TOP      3328
#define XB_TOPGEN   3392
#define XCD_BAR_WORDS 3456
#define XB_SPIN_CAP (1u << 22)
__device__ __forceinline__ unsigned xb_ld(unsigned* p)              { return __hip_atomic_load(p, __ATOMIC_RELAXED, __HIP_MEMORY_SCOPE_AGENT); }
__device__ __forceinline__ unsigned xb_add(unsigned* p, unsigned v) { return __hip_atomic_fetch_add(p, v, __ATOMIC_RELAXED, __HIP_MEMORY_SCOPE_AGENT); }
__device__ __forceinline__ unsigned xb_xcc_id() { return (unsigned)__builtin_amdgcn_s_getreg((3 << 11) | 20) & 0xFu; }
#define XB_SPIN(cond, bar) do { unsigned _sp = 0; while (cond) { __builtin_amdgcn_s_sleep(1); \
    if ((++_sp & 255u) == 0u) { if (xb_ld(&(bar)[XB_TMO])) break; if (_sp > XB_SPIN_CAP) { atomicAdd(&(bar)[XB_TMO], 1u); break; } } } } while (0)
struct XcdBarrier { unsigned* bar; unsigned x; volatile LAS unsigned* st; };
__device__ __forceinline__ XcdBarrier xcd_barrier_post(unsigned* bar, volatile LAS unsigned* st, int wave) {
    XcdBarrier b; b.bar = bar; b.x = xb_xcc_id(); b.st = st;
    if (wave == 0 && lane_id() == 0) (void)xb_add(&bar[XB_XCNT(b.x)], 1u);
    return b;
}
__device__ __forceinline__ void xcd_barrier_complete(unsigned* bar, unsigned x, unsigned& nloc, unsigned& nx) {
    const unsigned G = gridDim.x * gridDim.y * gridDim.z;
    unsigned sum, cnt, mine, sp = 0u;
    for (;;) {
        sum = 0u; cnt = 0u; mine = 0u;
#pragma unroll
        for (unsigned j = 0; j < 16; ++j) { const unsigned c = xb_ld(&bar[XB_XCNT(j)]); sum += c; cnt += (c > 0u) ? 1u : 0u; mine = (j == x) ? c : mine; }
        if (sum == G) break;
        __builtin_amdgcn_s_sleep(1);
        if ((++sp & 255u) == 0u) { if (xb_ld(&bar[XB_TMO])) break; if (sp > XB_SPIN_CAP) { atomicAdd(&bar[XB_TMO], 1u); break; } }
    }
    nloc = mine > 0u ? mine : 1u; nx = cnt > 0u ? cnt : 1u;
}
__device__ __forceinline__ void xcd_barrier(const XcdBarrier& b, int wave) {
    asm volatile("s_waitcnt vmcnt(0)" ::: "memory");
    __syncthreads();
    if (wave == 0 && lane_id() == 0) {
        unsigned* bar = b.bar;
        __builtin_amdgcn_s_waitcnt(0);
        unsigned nloc = b.st[0], nx = b.st[1];
        if (nloc == 0u) { xcd_barrier_complete(bar, b.x, nloc, nx); b.st[0] = nloc; b.st[1] = nx; }
        const unsigned old = xb_add(&bar[XB_XSUB(b.x)], 1u);
        const unsigned gen = old / nloc;
        if (old + 1u == (gen + 1u) * nloc) {
            __builtin_amdgcn_fence(__ATOMIC_RELEASE, "agent");
            asm volatile("s_waitcnt vmcnt(0)" ::: "memory");
            const unsigned og = xb_add(&bar[XB_TOP], 1u);
            const unsigned tg = og / nx;
            if (og + 1u == (tg + 1u) * nx) xb_add(&bar[XB_TOPGEN], 1u);
            else XB_SPIN(xb_ld(&bar[XB_TOPGEN]) == tg, bar);
            __builtin_amdgcn_fence(__ATOMIC_ACQUIRE, "agent");
            xb_add(&bar[XB_XGEN(b.x)], 1u);
            asm volatile("s_waitcnt vmcnt(0)" ::: "memory");
        } else {
            XB_SPIN(xb_ld(&bar[XB_XGEN(b.x)]) == gen, bar);
            __builtin_amdgcn_fence(__ATOMIC_ACQUIRE, "agent");
            asm volatile("s_waitcnt vmcnt(0)" ::: "memory");
        }
    }
    __syncthreads();
}

struct Args { const float* in[20]; float* out; unsigned char* ws; int ph_lo, ph_hi, li, pad; };
struct Frame {
    LAS unsigned char* lds;
    int wave, G;
};
typedef const __attribute__((address_space(4))) Args* CArgs;
#define IN_(i) (args->in[i])
#define P_x IN_(0)
#define P_rel_bias IN_(1)
#define P_attn_pre IN_(2)
#define P_attn_win IN_(3)
#define P_attn_wout IN_(4)
#define P_attn_post IN_(5)
#define P_ssm_pre IN_(6)
#define P_ssm_win IN_(7)
#define P_a_re IN_(8)
#define P_a_im IN_(9)
#define P_log_dt IN_(10)
#define P_b_re IN_(11)
#define P_b_im IN_(12)
#define P_c_re IN_(13)
#define P_c_im IN_(14)
#define P_dskip IN_(15)
#define P_w_glu IN_(16)
#define P_b_glu IN_(17)
#define P_ssm_wout IN_(18)
#define P_ssm_post IN_(19)
#define WSB(off) ((bf16*)(args->ws + (off)))
#define WSF(off) ((float*)(args->ws + (off)))
#define P_Wt_in WSB(WS_WT_IN)
#define P_Wt_ao WSB(WS_WT_AO)
#define P_Wt_si WSB(WS_WT_SI)
#define P_Wt_glu WSB(WS_WT_GLU)
#define P_Wt_so WSB(WS_WT_SO)
#define P_XN ((bf16*)args->out)
#define P_OG WSB(WS_OG)
#define P_Qh WSB(WS_Q)
#define P_Kh WSB(WS_K)
#define P_VTh WSB(WS_VT)
#define P_SZh WSB(WS_SZ)
#define P_XN2 WSB(WS_XN2)
#define P_UG WSB(WS_UG)
#define P_SZ2 WSB(WS_SZ2)
#define P_GB WSB(WS_GB)
#define P_Y2 WSB(WS_Y2)
#define P_H2 WSF(WS_H2)
#define P_H3 WSF(WS_H3)
#define P_small WSF(WS_SMALL)
#define P_out (args->out)


__device__ __forceinline__ void p0_transpose_item(const float* W, int K, int N, bf16* WT, LAS float* scr, int item, int lane) {
    const int nblk = N / 32, kb = item / nblk, nb = item % nblk, k0 = 64 * kb, n0 = 32 * nb;
#pragma unroll 8
    for (int i = 0; i < 32; ++i) { const int kk = 2 * i + (lane >> 5); scr[kk * 33 + (lane & 31)] = W[(size_t)(k0 + kk) * N + n0 + (lane & 31)]; }
    asm volatile("s_waitcnt lgkmcnt(0)" ::: "memory");
    const int c = lane & 7;
#pragma unroll
    for (int j = 0; j < 4; ++j) { const int n = (lane >> 3) + 8 * j; const LAS float* s = scr + (8 * c) * 33 + n;
        u32x4 o; o.x = pk2(s[0 * 33], s[1 * 33]); o.y = pk2(s[2 * 33], s[3 * 33]); o.z = pk2(s[4 * 33], s[5 * 33]); o.w = pk2(s[6 * 33], s[7 * 33]);
        *(GAS u32x4*)(WT + (size_t)(n0 + n) * K + k0 + 8 * c) = o; }
    asm volatile("s_waitcnt lgkmcnt(0)" ::: "memory");
}
__device__ __forceinline__ void rms_row_to_bf16(const float* xrow, const float* gain, bf16* orow, int lane) {
    const GAS f32x4* xr = (const GAS f32x4*)xrow + lane; const GAS f32x4* gr = (const GAS f32x4*)gain + lane;
    f32x4 v[4]; float s = 0.f;
#pragma unroll
    for (int j = 0; j < 4; ++j) { v[j] = xr[64 * j]; s += (v[j].x * v[j].x + v[j].y * v[j].y) + (v[j].z * v[j].z + v[j].w * v[j].w); }
    const float rs = 1.f / sqrtf(wave_sum(s) * (1.f / D) + EPS);
    GAS unsigned long long* o8 = (GAS unsigned long long*)orow + lane;
#pragma unroll
    for (int j = 0; j < 4; ++j) { const f32x4 g = gr[64 * j]; o8[64 * j] = (unsigned long long)pk2(v[j].x * rs * g.x, v[j].y * rs * g.y) | ((unsigned long long)pk2(v[j].z * rs * g.z, v[j].w * rs * g.w) << 32); }
}
__device__ __forceinline__ int t5_bucket(int dist) {
    const int n = dist < 1 ? 1 : dist;
    int large = 16 + (int)(logf((float)n / 16.f) / 4.852030263919617f * 16.f);
    large = large < 31 ? large : 31;
    return dist < 16 ? dist : large;
}
__device__ __forceinline__ void p0_prologue(Frame& F, CArgs args) {
    LAS float* scr = (LAS float*)(F.lds + F.wave * 16384);
    const int gw = blockIdx.x * 8 + F.wave, NGW = F.G * 8;
    constexpr int I_IN = (D / 64) * (NIN / 32), I_AO = (D / 64) * (D / 32), I_SI = (D / 64) * (2 * D / 32);
    constexpr int NITEMS = I_IN + I_AO + I_SI + I_AO + I_AO;
    for (int it = gw; it < NITEMS; it += NGW) {
        int r = it;
        if (r < I_IN) { p0_transpose_item(P_attn_win, D, NIN, P_Wt_in, scr, r, lane_id()); continue; } r -= I_IN;
        if (r < I_AO) { p0_transpose_item(P_attn_wout, D, D, P_Wt_ao, scr, r, lane_id()); continue; } r -= I_AO;
        if (r < I_SI) { p0_transpose_item(P_ssm_win, D, 2 * D, P_Wt_si, scr, r, lane_id()); continue; } r -= I_SI;
        if (r < I_AO) { p0_transpose_item(P_w_glu, D, D, P_Wt_glu, scr, r, lane_id()); continue; } r -= I_AO;
        p0_transpose_item(P_ssm_wout, D, D, P_Wt_so, scr, r, lane_id());
    }
    for (int m = gw; m < M; m += NGW) rms_row_to_bf16(P_x + (size_t)m * D, P_attn_pre, P_XN + (size_t)m * D, lane_id());
    const int gt = blockIdx.x * 512 + (F.wave * 64 + lane_id()), NGT = F.G * 512;
    for (int i = gt; i < 64 * 64; i += NGT) {
        const int g = i >> 6;
        const float are = P_a_re[i], aim = P_a_im[i], dt = __expf(P_log_dt[g]);
        const float xr = are * dt, yi = aim * dt;
        float sn, cs; sincosf(yi, &sn, &cs);
        const float ex = expf(xr);
        P_small[SM_LAM + 2 * i] = ex * cs; P_small[SM_LAM + 2 * i + 1] = ex * sn;
        float sn16, cs16; sincosf(16.f * yi, &sn16, &cs16); const float ex16 = expf(16.f * xr);
        P_small[SM_LAMT + 2 * i] = ex16 * cs16; P_small[SM_LAMT + 2 * i + 1] = ex16 * sn16;
        const float sh = sinf(0.5f * yi);
        const float nr = expm1f(xr) * cs - 2.f * sh * sh, ni = ex * sn;
        const float den = are * are + aim * aim;
        const float fr = (nr * are + ni * aim) / den, fi = (ni * are - nr * aim) / den;
        for (int c = 0; c < 16; ++c) {
            const float br = P_b_re[i * 16 + c], bi = P_b_im[i * 16 + c];
            P_small[SM_BBAR + (i * 16 + c) * 2] = fr * br - fi * bi;
            P_small[SM_BBAR + (i * 16 + c) * 2 + 1] = fr * bi + fi * br;
        }
    }
    for (int i = gt; i < 3 * 16 * 192; i += NGT) {
        const int dist = i % 192, hh = (i / 192) & 15, g = i / (192 * 16);
        float v = -1e30f;
        if (dist <= 128) v = P_rel_bias[t5_bucket(dist << (2 * g)) * 16 + hh] * LOG2E;
        P_small[SM_BIAS + i] = v;
    }
}

template <class Epi> __device__ __forceinline__ void naive_gemm(Frame& F, const bf16* A, const bf16* Bt, int Mrows, int N, int K, const Epi& epi) {
    const int ntn = N / 32, nt = (Mrows / 32) * ntn;
    const int gw = blockIdx.x * 8 + F.wave, NGW = F.G * 8;
    const int r32 = lane_id() & 31, hi = lane_id() >> 5;
    for (int tile = gw; tile < nt; tile += NGW) {
        const int tm = tile / ntn, tn = tile % ntn;
        f32x16 acc = {};
        const bf16* ap = A + (size_t)(tm * 32 + r32) * K + hi * 8;
        const bf16* bp = Bt + (size_t)(tn * 32 + r32) * K + hi * 8;
#pragma unroll 4
        for (int k = 0; k < K; k += 16) {
            const bf16x8 a = *(const GAS bf16x8*)(ap + k); const bf16x8 b = *(const GAS bf16x8*)(bp + k);
            acc = __builtin_amdgcn_mfma_f32_32x32x16_bf16(a, b, acc, 0, 0, 0);
        }
#pragma unroll
        for (int r = 0; r < 16; ++r) epi(tm * 32 + (r & 3) + 8 * (r >> 2) + 4 * hi, tn * 32 + r32, acc[r]);
    }
}
struct EnInProj {
    bf16 *Qh, *Kh, *VTh, *SZh;
    __device__ __forceinline__ void operator()(int m, int n, float v) const {
        const int bl = m >> 11, t = m & 2047;
        if (n < 9216) {
            const int tq = n / 3072, rem = n % 3072, g = rem >> 10, hh = (rem >> 6) & 15, e = rem & 63, sh = 2 * g;
            const int row = (t & ((1 << sh) - 1)) * (2048 >> sh) + (t >> sh);
            const size_t hb = (size_t)((bl * 3 + g) * 16 + hh);
            if (tq == 0) Qh[(hb * 2048 + row) * 64 + e] = (bf16)f2bf(v * C2);
            else if (tq == 1) Kh[(hb * 2048 + row) * 64 + e] = (bf16)f2bf(v);
            else VTh[(hb * 64 + e) * 2048 + row] = (bf16)f2bf(v);
        } else SZh[(size_t)m * 1024 + (n - 9216)] = (bf16)f2bf(silu_f(v));
    }
};
struct EnF32 { float* out; __device__ __forceinline__ void operator()(int m, int n, float v) const { out[(size_t)m * 1024 + n] = v; } };
struct EnSsmIn {
    bf16 *UG, *SZ2;
    __device__ __forceinline__ void operator()(int m, int n, float v) const {
        if (n < 1024) { const int g = n >> 4, c = n & 15, b = m >> 11, t = m & 2047; UG[((size_t)(b * 64 + g) * 2048 + t) * 16 + c] = (bf16)f2bf(v); }
        else SZ2[(size_t)m * 1024 + (n - 1024)] = (bf16)f2bf(silu_f(v));
    }
};
struct EnGlu {
    const bf16 *GB, *SZ2; const float* bglu; bf16* Y2;
    __device__ __forceinline__ void operator()(int m, int n, float v) const {
        const size_t o = (size_t)m * 1024 + n; const float gv = bf2f(GB[o]);
        Y2[o] = (bf16)f2bf(gv * sigmoid_f(v + bglu[n]) * bf2f(SZ2[o]));
    }
};

namespace pg8 {
constexpr int BM = 256, BK = 64, HALF = 128, HTB = HALF * BK * 2, STAGE_BYTES = 8 * HTB, NXCD = 8, WGM = 8;
__host__ __device__ __forceinline__ int lds_byte(int r, int c) { const int st = (r >> 4) * 2 + (c >> 5), rr = r & 15, cc = c & 31, ob = rr * 64 + cc * 2; return st * 1024 + (ob ^ (((ob >> 9) & 1) << 5)); }
__host__ __device__ __forceinline__ void stage_rc(int b, int& R, int& C) { const int st = b / 1024, sb = b % 1024, swz = sb ^ (((sb >> 9) & 1) << 5); R = (st >> 1) * 16 + swz / 64; C = (st & 1) * 32 + (swz % 64) / 2; }
__host__ __device__ __forceinline__ int perm32(int rho) { const int n = rho >> 4, i = rho & 15; return 8 * (i >> 2) + 4 * n + (i & 3); }
struct Unit { int pm, pn; };
struct StaticOrder {
    int nM, nN, nwg, G, c;
    __host__ __device__ void init(int M_, int N_, int G_, int c_) { nM = M_ / BM; nN = N_ / BM; nwg = nM * nN; G = G_; c = c_; }
    __host__ __device__ bool next(int i, Unit& u) const {
        const long L = (long)i * G + c; if (L >= nwg) return false;
        int wgid = (int)L; { const int q = nwg / NXCD, r = nwg % NXCD, xcd = wgid % NXCD, off = wgid / NXCD; wgid = (xcd < r ? xcd * (q + 1) : r * (q + 1) + (xcd - r) * q) + off; }
        const int nig = WGM * nN, gid = wgid / nig, fm = gid * WGM, gsz = (nM - fm) < WGM ? (nM - fm) : WGM;
        u.pm = fm + ((wgid % nig) % gsz); u.pn = (wgid % nig) / gsz; return true;
    }
};
__device__ __forceinline__ unsigned cvt_pk_bf16(float lo, float hi) { unsigned r; asm volatile("v_cvt_pk_bf16_f32 %0, %1, %2" : "=v"(r) : "v"(lo), "v"(hi)); return r; }
__device__ __forceinline__ u32x4 pack8(const f32x4& v0, const f32x4& v1) { u32x4 w; w.x = cvt_pk_bf16(v0[0], v0[1]); w.y = cvt_pk_bf16(v0[2], v0[3]); w.z = cvt_pk_bf16(v1[0], v1[1]); w.w = cvt_pk_bf16(v1[2], v1[3]); return w; }

struct ProbPlain {
    const bf16* A; const bf16* Bt; int K;
    static constexpr int NKIND = 1;
    __device__ __forceinline__ void operands(const Unit& u, const char*& cA, const char*& cB, int& kind) const {
        cA = (const char*)A + (size_t)u.pm * 256 * K * 2; cB = (const char*)Bt + (size_t)u.pn * 256 * K * 2; kind = 0; }
    __device__ __forceinline__ int brow(int kind, int cl) const { return cl; }
};
struct ProbInProj {
    const bf16* A; const bf16* Bt; int K;
    static constexpr int NKIND = 3;
    __device__ __forceinline__ void operands(const Unit& u, const char*& cA, const char*& cB, int& kind) const {
        const char* a = (const char*)A + (size_t)u.pm * 256 * K * 2; const char* b = (const char*)Bt + (size_t)u.pn * 256 * K * 2;
        const bool sw = (u.pn >= 24 && u.pn < 36);
        cA = sw ? b : a; cB = sw ? a : b; kind = sw ? ((u.pn - 24) >> 2) : 0; }
    __device__ __forceinline__ int brow(int kind, int cl) const { return kind == 0 ? cl : (kind == 1 ? 4 * (cl & 31) + (cl >> 5) : 16 * (cl & 7) + (cl >> 3)); }
};

struct EpiF32 {
    static constexpr bool PERM = false;
    float* C; int ldc;
    __device__ __forceinline__ void operator()(const f32x4 (&acc)[2][2][4][2], const Unit& u, int wr, int wc, int fr, int fq) const {
        const int row0 = u.pm * BM + wr * 64 + fr, col0 = u.pn * BM + wc * 32 + 4 * fq;
#pragma unroll
        for (int ai = 0; ai < 2; ++ai)
#pragma unroll
            for (int m = 0; m < 4; ++m) { float* rowp = C + (size_t)(row0 + ai * HALF + m * 16) * ldc + col0;
#pragma unroll
                for (int bj = 0; bj < 2; ++bj)
#pragma unroll
                    for (int n = 0; n < 2; ++n) *(f32x4*)(rowp + bj * HALF + n * 16) = acc[ai][bj][m][n]; }
    }
};
struct EpiInProj {
    static constexpr bool PERM = true;
    bf16 *Qh, *Kh, *VTh, *SZh;
    __device__ __forceinline__ void operator()(const f32x4 (&acc)[2][2][4][2], const Unit& u, int wr, int wc, int fr, int fq) const {
        if (u.pn < 24) {
            const int tq = u.pn >= 12 ? 1 : 0, pnn = u.pn - 12 * tq, g = pnn >> 2, sh = 2 * g, hq = (pnn & 3) * 4;
            const float sc = tq ? 1.f : C2; bf16* base = tq ? Kh : Qh;
#pragma unroll
            for (int ai = 0; ai < 2; ++ai)
#pragma unroll
                for (int m = 0; m < 4; ++m) {
                    const int rowl = u.pm * BM + ai * HALF + wr * 64 + m * 16 + fr, bl = rowl >> 11, t = rowl & 2047;
                    const int row = (t & ((1 << sh) - 1)) * (2048 >> sh) + (t >> sh);
#pragma unroll
                    for (int bj = 0; bj < 2; ++bj) { const int c8 = bj * HALF + wc * 32 + 8 * fq, hh = hq + (c8 >> 6), e0 = c8 & 63;
                        bf16* dst = base + ((size_t)((bl * 3 + g) * 16 + hh) * 2048 + row) * 64 + e0;
                        *(u32x4*)dst = pack8(acc[ai][bj][m][0] * sc, acc[ai][bj][m][1] * sc); } }
        } else if (u.pn < 36) {
            const int pv = u.pn - 24, g = pv >> 2, hq = (pv & 3) * 4, bl = u.pm >> 3, t0 = (u.pm & 7) * 256;
#pragma unroll
            for (int ai = 0; ai < 2; ++ai)
#pragma unroll
                for (int m = 0; m < 4; ++m) {
                    const int r = ai * HALF + wr * 64 + m * 16 + fr, hh = hq + (r >> 6), e = r & 63;
                    bf16* rowp = VTh + ((size_t)((bl * 3 + g) * 16 + hh) * 64 + e) * 2048;
#pragma unroll
                    for (int bj = 0; bj < 2; ++bj) { const int th = t0 + HALF * bj;
                        const int pos = g == 0 ? th + 32 * wc + 8 * fq : (g == 1 ? wc * 512 + (th >> 2) + 8 * fq : (4 * wc + fq) * 128 + (th >> 4));
                        *(u32x4*)(rowp + pos) = pack8(acc[ai][bj][m][0], acc[ai][bj][m][1]); } }
        } else {
#pragma unroll
            for (int ai = 0; ai < 2; ++ai)
#pragma unroll
                for (int m = 0; m < 4; ++m) {
                    const int rowl = u.pm * BM + ai * HALF + wr * 64 + m * 16 + fr;
#pragma unroll
                    for (int bj = 0; bj < 2; ++bj) { const int col = (u.pn - 36) * BM + bj * HALF + wc * 32 + 8 * fq;
                        f32x4 v0 = acc[ai][bj][m][0], v1 = acc[ai][bj][m][1];
#pragma unroll
                        for (int j = 0; j < 4; ++j) { v0[j] = silu_f(v0[j]); v1[j] = silu_f(v1[j]); }
                        *(u32x4*)(SZh + (size_t)rowl * 1024 + col) = pack8(v0, v1); } }
        }
    }
};
struct EpiSsmIn {
    static constexpr bool PERM = true;
    bf16 *UG, *SZ2;
    __device__ __forceinline__ void operator()(const f32x4 (&acc)[2][2][4][2], const Unit& u, int wr, int wc, int fr, int fq) const {
#pragma unroll
        for (int ai = 0; ai < 2; ++ai)
#pragma unroll
            for (int m = 0; m < 4; ++m) {
                const int row = u.pm * BM + ai * HALF + wr * 64 + m * 16 + fr, b = row >> 11, t = row & 2047;
#pragma unroll
                for (int bj = 0; bj < 2; ++bj) { const int col = u.pn * BM + bj * HALF + wc * 32 + 8 * fq;
                    f32x4 v0 = acc[ai][bj][m][0], v1 = acc[ai][bj][m][1];
                    if (u.pn < 4) { const int g = col >> 4, c0 = col & 15; *(u32x4*)(UG + ((size_t)(b * 64 + g) * 2048 + t) * 16 + c0) = pack8(v0, v1); }
                    else {
#pragma unroll
                        for (int j = 0; j < 4; ++j) { v0[j] = silu_f(v0[j]); v1[j] = silu_f(v1[j]); }
                        *(u32x4*)(SZ2 + (size_t)row * 1024 + (col - 1024)) = pack8(v0, v1); } } }
    }
};
struct EpiGlu {
    static constexpr bool PERM = true;
    const bf16 *GB, *SZ2; const float* bglu; bf16* Y2;
    __device__ __forceinline__ void operator()(const f32x4 (&acc)[2][2][4][2], const Unit& u, int wr, int wc, int fr, int fq) const {
#pragma unroll
        for (int ai = 0; ai < 2; ++ai)
#pragma unroll
            for (int m = 0; m < 4; ++m) {
                const int row = u.pm * BM + ai * HALF + wr * 64 + m * 16 + fr;
#pragma unroll
                for (int bj = 0; bj < 2; ++bj) { const int col = u.pn * BM + bj * HALF + wc * 32 + 8 * fq; const size_t o = (size_t)row * 1024 + col;
                    const u32x4 gq = *(const u32x4*)(GB + o), sq = *(const u32x4*)(SZ2 + o);
                    const f32x4 b0 = *(const f32x4*)(bglu + col), b1 = *(const f32x4*)(bglu + col + 4);
                    f32x4 v0 = acc[ai][bj][m][0] + b0, v1 = acc[ai][bj][m][1] + b1;
#pragma unroll
                    for (int j = 0; j < 4; ++j) {
                        const unsigned gw0 = gq[j >> 1], sw0 = sq[j >> 1], gw1 = gq[2 + (j >> 1)], sw1 = sq[2 + (j >> 1)];
                        const float g0 = __builtin_bit_cast(float, (j & 1) ? (gw0 & 0xffff0000u) : (gw0 << 16)), s0 = __builtin_bit_cast(float, (j & 1) ? (sw0 & 0xffff0000u) : (sw0 << 16));
                        const float g1 = __builtin_bit_cast(float, (j & 1) ? (gw1 & 0xffff0000u) : (gw1 << 16)), s1 = __builtin_bit_cast(float, (j & 1) ? (sw1 & 0xffff0000u) : (sw1 << 16));
                        v0[j] = g0 * sigmoid_f(v0[j]) * s0; v1[j] = g1 * sigmoid_f(v1[j]) * s1; }
                    *(u32x4*)(Y2 + o) = pack8(v0, v1); } }
    }
};

template <class Epi, class Prob, bool ALIGN_EPI>
__device__ __forceinline__ void gemm_phase(LAS unsigned char* lds, int wave_id, const Prob P, const StaticOrder& S, const Epi& E) {
    int lane_ = lane_id(); asm volatile("" : "+v"(lane_));
    const int wid = wave_id, lane = lane_, tid = wid * 64 + lane, wr = wid >> 2, wc = wid & 3, fr = lane & 15, fq = lane >> 4;
    const int K = P.K, nt = K / BK;
    unsigned voffA[2], voffB[2];
#pragma unroll
    for (int i = 0; i < 2; ++i) { int R, C; stage_rc(tid * 16 + i * 8192, R, C); voffA[i] = (unsigned)(R * K + C) * 2u; }
#define PG8_SET_VOFFB(kind_) do { int l2_ = lane_id(); asm volatile("" : "+v"(l2_)); const int t2_ = wid * 64 + l2_; _Pragma("unroll") for (int i = 0; i < 2; ++i) { int R, C; stage_rc(t2_ * 16 + i * 8192, R, C); \
        const int cl = Epi::PERM ? ((R & ~31) + perm32(R & 31)) : R; voffB[i] = (unsigned)(P.brow((kind_), cl) * K + C) * 2u; } } while (0)
    const size_t kstep = (size_t)(BK * 2);
    const size_t hstep = (size_t)HALF * K * 2;
    const unsigned ldsw = (unsigned)wid * 1024u;
    const int aoff = lds_byte(wr * 64 + fr, fq * 8), boff = lds_byte(wc * 32 + fr, fq * 8);
#define PG8_SA(b, h) (((b) * 2 + (h)) * HTB)
#define PG8_SB(b, h) ((4 + (b) * 2 + (h)) * HTB)
#define PG8_STAGE(bufoff, gbase, voff) do { _Pragma("unroll") for (int _i = 0; _i < 2; ++_i) \
        __builtin_amdgcn_global_load_lds((const unsigned*)((const char*)(gbase) + (voff)[_i]), (LAS unsigned*)(lds + (bufoff) + ldsw + _i * 8192), 16, 0, 0); } while (0)
#define PG8_LDA(dst, b, h) do { _Pragma("unroll") for (int m = 0; m < 4; ++m) _Pragma("unroll") for (int k = 0; k < 2; ++k) dst[m][k] = *(const LAS bf16x8*)(lds + PG8_SA(b, h) + aoff + m * 2048 + k * 1024); } while (0)
#define PG8_LDB(dst, b, h) do { _Pragma("unroll") for (int n = 0; n < 2; ++n) _Pragma("unroll") for (int k = 0; k < 2; ++k) dst[n][k] = *(const LAS bf16x8*)(lds + PG8_SB(b, h) + boff + n * 2048 + k * 1024); } while (0)
#define PG8_MMA(ai, bj, At, Bt) do { __builtin_amdgcn_s_setprio(1); _Pragma("unroll") for (int m = 0; m < 4; ++m) _Pragma("unroll") for (int n = 0; n < 2; ++n) _Pragma("unroll") for (int k = 0; k < 2; ++k) \
        acc[ai][bj][m][n] = __builtin_amdgcn_mfma_f32_16x16x32_bf16(Bt[n][k], At[m][k], acc[ai][bj][m][n], 0, 0, 0); __builtin_amdgcn_s_setprio(0); } while (0)
#define PG8_WAIT_V(n) asm volatile("s_waitcnt vmcnt(" #n ")" ::: "memory")
#define PG8_WAIT_L(n) asm volatile("s_waitcnt lgkmcnt(" #n ")" ::: "memory")
#define PG8_BAR __builtin_amdgcn_s_barrier()
#define PG8_SCHED __builtin_amdgcn_sched_barrier(0)
    Unit cur, nxt; int ui = 0;
    if (!S.next(0, cur)) return;
    f32x4 acc[2][2][4][2];
#pragma unroll
    for (int a = 0; a < 2; ++a)
#pragma unroll
        for (int b = 0; b < 2; ++b)
#pragma unroll
            for (int m = 0; m < 4; ++m)
#pragma unroll
                for (int n = 0; n < 2; ++n) acc[a][b][m][n] = (f32x4){0.f, 0.f, 0.f, 0.f};
    bf16x8 At[4][2], B0[2][2], B1[2][2];
    const char *cA, *cB; int ckind; P.operands(cur, cA, cB, ckind);
    PG8_SET_VOFFB(ckind);
    PG8_STAGE(PG8_SB(0, 0), cB, voffB); PG8_STAGE(PG8_SB(0, 1), cB + hstep, voffB); PG8_STAGE(PG8_SA(0, 0), cA, voffA); PG8_STAGE(PG8_SA(0, 1), cA + hstep, voffA);
    if (wr == 1) PG8_BAR;
    PG8_WAIT_V(2); PG8_BAR;
    PG8_STAGE(PG8_SB(1, 0), cB + kstep, voffB); PG8_STAGE(PG8_SA(1, 0), cA + kstep, voffA); PG8_STAGE(PG8_SB(1, 1), cB + hstep + kstep, voffB);
    PG8_WAIT_V(6); PG8_BAR;
    for (;;) {
        const bool has_next = S.next(ui + 1, nxt);
        const char *nA = cA, *nB = cB; int nkind = ckind;
        if (has_next) P.operands(nxt, nA, nB, nkind);
        for (int t = 0; t < nt; t += 2) {
            const bool last = (t == nt - 2);
            const char* a1 = cA + (size_t)(t + 1) * kstep;
            const char* a2 = last ? nA : cA + (size_t)(t + 2) * kstep; const char* b2 = last ? nB : cB + (size_t)(t + 2) * kstep;
            const char* a3 = a2 + kstep; const char* b3 = b2 + kstep;
            if (Prob::NKIND > 1 && last && nkind != ckind) PG8_SET_VOFFB(nkind);
            PG8_LDB(B0, 0, 0); PG8_LDB(B1, 0, 1); PG8_SCHED; PG8_LDA(At, 0, 0); PG8_STAGE(PG8_SA(1, 1), a1 + hstep, voffA);
            PG8_WAIT_V(8); PG8_WAIT_L(0); PG8_BAR; PG8_MMA(0, 0, At, B0); PG8_MMA(0, 1, At, B1); PG8_BAR; PG8_SCHED;
            PG8_LDA(At, 0, 1); PG8_STAGE(PG8_SB(0, 0), b2, voffB); PG8_STAGE(PG8_SB(0, 1), b2 + hstep, voffB); PG8_STAGE(PG8_SA(0, 0), a2, voffA);
            PG8_WAIT_V(8); PG8_WAIT_L(0); PG8_BAR; PG8_MMA(1, 0, At, B0); PG8_MMA(1, 1, At, B1); PG8_BAR; PG8_SCHED;
            PG8_LDB(B0, 1, 0); PG8_LDB(B1, 1, 1); PG8_SCHED; PG8_LDA(At, 1, 0); PG8_STAGE(PG8_SA(0, 1), a2 + hstep, voffA);
            PG8_WAIT_V(8); PG8_WAIT_L(0); PG8_BAR; PG8_MMA(0, 0, At, B0); PG8_MMA(0, 1, At, B1); PG8_BAR; PG8_SCHED;
            PG8_LDA(At, 1, 1); PG8_STAGE(PG8_SB(1, 0), b3, voffB); PG8_STAGE(PG8_SB(1, 1), b3 + hstep, voffB); PG8_STAGE(PG8_SA(1, 0), a3, voffA);
            PG8_WAIT_V(8); PG8_WAIT_L(0); PG8_BAR; PG8_MMA(1, 0, At, B0); PG8_MMA(1, 1, At, B1); PG8_BAR; PG8_SCHED;
        }
        if constexpr (ALIGN_EPI) { if (wr == 0) PG8_BAR; }
        E(acc, cur, wr, wc, fr, fq);
        if (!has_next) break;
#pragma unroll
        for (int a = 0; a < 2; ++a)
#pragma unroll
            for (int b = 0; b < 2; ++b)
#pragma unroll
                for (int m = 0; m < 4; ++m)
#pragma unroll
                    for (int n = 0; n < 2; ++n) acc[a][b][m][n] = (f32x4){0.f, 0.f, 0.f, 0.f};
        cur = nxt; cA = nA; cB = nB; ckind = nkind; ++ui;
        if constexpr (ALIGN_EPI) { if (wr == 1) PG8_BAR; }
    }
    PG8_WAIT_V(0);
    if constexpr (!ALIGN_EPI) { if (wr == 0) PG8_BAR; }
    PG8_BAR;
#undef PG8_SET_VOFFB
#undef PG8_SA
#undef PG8_SB
#undef PG8_STAGE
#undef PG8_LDA
#undef PG8_LDB
#undef PG8_MMA
#undef PG8_WAIT_V
#undef PG8_WAIT_L
#undef PG8_BAR
#undef PG8_SCHED
}
}

namespace att {
constexpr int AT_OL = 0, AT_LSE = 131072, AT_TAB = 135168;
constexpr float NEGV = -1e30f;
__device__ __forceinline__ int swap23(int i) { return (i & ~12) | ((i & 4) << 1) | ((i & 8) >> 1); }
__device__ __forceinline__ float swapmax(float m) { return fmaxf(m, __shfl_xor(m, 32)); }
__device__ __forceinline__ float swapsum(float m) { return m + __shfl_xor(m, 32); }
typedef float f32x2_t __attribute__((ext_vector_type(2))); typedef __bf16 bf16x2_t __attribute__((ext_vector_type(2)));
__device__ __forceinline__ unsigned cvtpk(float lo, float hi) { f32x2_t v = {lo, hi}; bf16x2_t b = __builtin_convertvector(v, bf16x2_t); return __builtin_bit_cast(unsigned, b); }
__device__ __forceinline__ int olds_off(int row, int col8) { return row * 128 + ((col8 ^ ((row ^ (row >> 4)) & 15)) << 3); }

__device__ __forceinline__ void task(const bf16* Qp, const bf16* Kp, const bf16* Vp, int m0, const LAS float* tab, int lane, f32x16& o0, f32x16& o1, float& mrow, float& lrow) {
    const int q = lane & 31, hi = lane >> 5;
    const int jmin = m0 >= 128 ? 0 : ((128 - m0) >> 5);
    bf16x8 qf[4];
    { const bf16* qrow = Qp + (size_t)(m0 + q) * 64 + hi * 8;
#pragma unroll
      for (int ks = 0; ks < 4; ++ks) qf[ks] = *(const GAS bf16x8*)(qrow + 16 * ks); }
    const bf16* krow = Kp + ((ptrdiff_t)(m0 - 128 + swap23(q))) * 64 + hi * 8;
    bf16x8 kf[5][4];
#pragma unroll
    for (int j = 0; j < 5; ++j) if (j >= jmin) {
#pragma unroll
        for (int ks = 0; ks < 4; ++ks) kf[j][ks] = *(const GAS bf16x8*)(krow + j * 32 * 64 + 16 * ks); }
    f32x16 s[5];
#pragma unroll
    for (int j = 0; j < 5; ++j) {
#pragma unroll
        for (int r = 0; r < 16; ++r) s[j][r] = 0.f;
        if (j >= jmin) {
#pragma unroll
            for (int ks = 0; ks < 4; ++ks) s[j] = __builtin_amdgcn_mfma_f32_32x32x16_bf16(kf[j][ks], qf[ks], s[j], 0, 0, 0); } }
    __builtin_amdgcn_sched_barrier(0);
    const bf16* vrow = Vp + (size_t)q * 2048 + (m0 - 128) + 8 * hi;
    bf16x8 vf[5][2][2];
#pragma unroll
    for (int j = 0; j < 5; ++j) if (j >= jmin) {
#pragma unroll
        for (int s2 = 0; s2 < 2; ++s2) { vf[j][s2][0] = *(const GAS bf16x8*)(vrow + 32 * j + 16 * s2); vf[j][s2][1] = *(const GAS bf16x8*)(vrow + 32 * 2048 + 32 * j + 16 * s2); } }
    const LAS float* tb = tab + (4 + q - 8 * hi);
    float mx = -3e38f;
#pragma unroll
    for (int j = 0; j < 5; ++j) if (j >= jmin) {
#pragma unroll
        for (int r = 0; r < 16; ++r) { const int cr = (r & 3) + 4 * ((r >> 2) & 1) + 16 * (r >> 3); s[j][r] += tb[155 - 32 * j - cr]; mx = fmaxf(mx, s[j][r]); } }
    mx = swapmax(mx);
    float ls = 0.f;
#pragma unroll
    for (int j = 0; j < 5; ++j) if (j >= jmin) {
#pragma unroll
        for (int r = 0; r < 16; ++r) { const float p = __builtin_amdgcn_exp2f(s[j][r] - mx); s[j][r] = p; ls += p; } }
    ls = swapsum(ls);
#pragma unroll
    for (int r = 0; r < 16; ++r) { o0[r] = 0.f; o1[r] = 0.f; }
#pragma unroll
    for (int j = 0; j < 5; ++j) if (j >= jmin) {
#pragma unroll
        for (int s2 = 0; s2 < 2; ++s2) {
            u32x4 pw; pw.x = cvtpk(s[j][8 * s2 + 0], s[j][8 * s2 + 1]); pw.y = cvtpk(s[j][8 * s2 + 2], s[j][8 * s2 + 3]); pw.z = cvtpk(s[j][8 * s2 + 4], s[j][8 * s2 + 5]); pw.w = cvtpk(s[j][8 * s2 + 6], s[j][8 * s2 + 7]);
            const bf16x8 pf = __builtin_bit_cast(bf16x8, pw);
            o0 = __builtin_amdgcn_mfma_f32_32x32x16_bf16(vf[j][s2][0], pf, o0, 0, 0, 0);
            o1 = __builtin_amdgcn_mfma_f32_32x32x16_bf16(vf[j][s2][1], pf, o1, 0, 0, 0); } }
    mrow = mx; lrow = ls;
}

__device__ __forceinline__ void attn_phase(Frame& F, CArgs args, int half) {
    int lane_ = lane_id(); asm volatile("" : "+v"(lane_));
    const int lane = lane_, wave = F.wave, q = lane & 31, hi = lane >> 5;
    LAS unsigned char* lds = F.lds;
    LAS float* tabs = (LAS float*)(lds + AT_TAB);
    LAS float* lses = (LAS float*)(lds + AT_LSE);
    for (int u = blockIdx.x; u < 256; u += F.G) {
        const int c = u & 3, hh = (u >> 2) & 15, bl = u >> 6;
        for (int i = (F.wave * 64 + lane_id()); i < 3 * 192; i += 512) { const int g = i / 192, idx = i % 192, dist = idx - 31;
            tabs[i] = (dist >= 0 && dist <= 128) ? P_small[SM_BIAS + (g * 16 + hh) * 192 + dist] : NEGV; }
        __syncthreads();
        for (int tk = wave; tk < 32; tk += 8) {
            const int g = tk < 16 ? 2 : 1, k = tk & 15;
            const int r_ = g == 2 ? k : (k >> 2), a = g == 2 ? 0 : (k & 3);
            const int sh = 2 * g, L = 2048 >> sh;
            const int m0 = g == 2 ? 32 * c : 128 * c + 32 * a;
            const size_t hb = (size_t)((bl * 3 + g) * 16 + hh);
            const bf16* Qp = P_Qh + (hb * 2048 + (size_t)r_ * L) * 64; const bf16* Kp = P_Kh + (hb * 2048 + (size_t)r_ * L) * 64; const bf16* Vp = P_VTh + hb * 64 * 2048 + (size_t)r_ * L;
            f32x16 o0, o1; float mr, lr;
            task(Qp, Kp, Vp, m0, tabs + g * 192, lane, o0, o1, mr, lr);
            const float inv = 1.f / lr;
            const int row = g == 2 ? 16 * q + r_ : 4 * (32 * a + q) + r_;
            LAS unsigned char* ob = lds + AT_OL + (g == 2 ? 65536 : 0);
#pragma unroll
            for (int d0 = 0; d0 < 2; ++d0)
#pragma unroll
                for (int r4 = 0; r4 < 4; ++r4) { const f32x16& o = d0 ? o1 : o0;
                    u32x2 w; w.x = cvtpk(o[4 * r4] * inv, o[4 * r4 + 1] * inv); w.y = cvtpk(o[4 * r4 + 2] * inv, o[4 * r4 + 3] * inv);
                    *(LAS u32x2*)(ob + olds_off(row, 8 * d0 + 2 * r4 + hi)) = w; }
            if (hi == 0) lses[(g == 2 ? 512 : 0) + row] = mr + log2f(lr);
        }
        __syncthreads();
        for (int j0 = wave; j0 < 16; j0 += 8) {
            const size_t hb = (size_t)((bl * 3 + 0) * 16 + hh);
            const bf16* Qp = P_Qh + hb * 2048 * 64; const bf16* Kp = P_Kh + hb * 2048 * 64; const bf16* Vp = P_VTh + hb * 64 * 2048;
            f32x16 o0, o1; float mr, lr;
            task(Qp, Kp, Vp, 512 * c + 32 * j0, tabs, lane, o0, o1, mr, lr);
            const int row = 32 * j0 + q;
            const float l0 = mr + log2f(lr), l1 = lses[row], l2 = lses[512 + row];
            const float mt = fmaxf(fmaxf(l0, l1), l2);
            float w0 = __builtin_amdgcn_exp2f(l0 - mt), w1 = __builtin_amdgcn_exp2f(l1 - mt), w2 = __builtin_amdgcn_exp2f(l2 - mt);
            const float wi = 1.f / (w0 + w1 + w2); w0 *= wi / lr; w1 *= wi; w2 *= wi;
            const size_t ml = (size_t)bl * 2048 + 512 * c + row;
            const bf16* szp = P_SZh + ml * 1024 + hh * 64; bf16* ogp = P_OG + ((size_t)half * HM + ml) * 1024 + hh * 64;
#pragma unroll
            for (int d0 = 0; d0 < 2; ++d0)
#pragma unroll
                for (int r4 = 0; r4 < 4; ++r4) { const f32x16& o = d0 ? o1 : o0; const int col8 = 8 * d0 + 2 * r4 + hi;
                    const u32x2 a1 = *(const LAS u32x2*)(lds + AT_OL + olds_off(row, col8)), a2 = *(const LAS u32x2*)(lds + AT_OL + 65536 + olds_off(row, col8));
                    const u32x2 zz = *(const GAS u32x2*)(szp + 4 * col8);
                    float v[4];
#pragma unroll
                    for (int e = 0; e < 4; ++e) {
                        const unsigned x1 = e < 2 ? a1.x : a1.y, x2 = e < 2 ? a2.x : a2.y, xz = e < 2 ? zz.x : zz.y;
                        const float f1 = __builtin_bit_cast(float, (e & 1) ? (x1 & 0xffff0000u) : (x1 << 16)), f2 = __builtin_bit_cast(float, (e & 1) ? (x2 & 0xffff0000u) : (x2 << 16));
                        const float fz = __builtin_bit_cast(float, (e & 1) ? (xz & 0xffff0000u) : (xz << 16));
                        v[e] = (w0 * o[4 * r4 + e] + w1 * f1 + w2 * f2) * fz; }
                    u32x2 w; w.x = cvtpk(v[0], v[1]); w.y = cvtpk(v[2], v[3]);
                    *(GAS u32x2*)(ogp + 4 * col8) = w; }
        }
        __syncthreads();
    }
}
}

__device__ __forceinline__ void naive_attn(Frame& F, CArgs args, int half) {
    const int gw = blockIdx.x * 8 + F.wave, NGW = F.G * 8, lane = lane_id();
    const float* bias = P_small + SM_BIAS;
    for (int it = gw; it < 4 * 2048 * 16; it += NGW) {
        const int hh = it & 15, t = (it >> 4) & 2047, bl = it >> 15;
        float og[3], lse[3];
#pragma unroll
        for (int g = 0; g < 3; ++g) {
            const int sh = 2 * g, L = 2048 >> sh, r_ = t & ((1 << sh) - 1), m_ = t >> sh;
            const size_t hb = (size_t)((bl * 3 + g) * 16 + hh);
            const size_t rowq = hb * 2048 + r_ * L + m_;
            const float qe = bf2f(P_Qh[rowq * 64 + lane]);
            float s0 = -INFINITY, s1 = -INFINITY, s2 = -INFINITY;
            const int jmax = m_ < 128 ? m_ : 128;
            const float* bt = bias + (g * 16 + hh) * 192;
            for (int j = 0; j <= jmax; ++j) {
                const float kv = bf2f(P_Kh[(rowq - j) * 64 + lane]);
                const float tot = wave_sum(qe * kv) + bt[j];
                if (j < 64) { if (lane == j) s0 = tot; } else if (j < 128) { if (lane == j - 64) s1 = tot; } else { if (lane == 0) s2 = tot; }
            }
            const float mx = wave_max(fmaxf(fmaxf(s0, s1), s2));
            const float p0 = exp2f(s0 - mx), p1 = exp2f(s1 - mx), p2 = exp2f(s2 - mx);
            const float sum = wave_sum(p0 + p1 + p2);
            float o = 0.f;
            const bf16* vp = P_VTh + (hb * 64 + lane) * 2048 + r_ * L + m_;
            for (int j = 0; j <= jmax; ++j) {
                const float pj = __shfl(j < 64 ? p0 : (j < 128 ? p1 : p2), j & 63);
                o += pj * bf2f(vp[-j]);
            }
            og[g] = o / sum; lse[g] = mx + log2f(sum);
        }
        const float mx = fmaxf(fmaxf(lse[0], lse[1]), lse[2]);
        const float w0 = exp2f(lse[0] - mx), w1 = exp2f(lse[1] - mx), w2 = exp2f(lse[2] - mx);
        const float o = (w0 * og[0] + w1 * og[1] + w2 * og[2]) / (w0 + w1 + w2);
        const size_t ml = (size_t)bl * 2048 + t;
        const float sz = bf2f(P_SZh[ml * 1024 + hh * 64 + lane]);
        P_OG[((size_t)half * HM + ml) * 1024 + hh * 64 + lane] = (bf16)f2bf(o * sz);
    }
}

__device__ __forceinline__ void naive_scan(Frame& F, CArgs args) {
    const int gw = blockIdx.x * 8 + F.wave, NGW = F.G * 8, lane = lane_id();
    for (int it = gw; it < 8 * 64; it += NGW) {
        const int g = it & 63, b = it >> 6;
        const int gp = g * 64 + lane;
        const float lr = P_small[SM_LAM + 2 * gp], li = P_small[SM_LAM + 2 * gp + 1];
        float xr = 0.f, xi = 0.f;
        const bf16* up = P_UG + (size_t)(b * 64 + g) * 2048 * 16;
        const float dsk = P_dskip[g * 16 + (lane & 15)];
        float bbr[16], bbi[16], ccr[16], cci[16];
#pragma unroll
        for (int c = 0; c < 16; ++c) { bbr[c] = P_small[SM_BBAR + (gp * 16 + c) * 2]; bbi[c] = P_small[SM_BBAR + (gp * 16 + c) * 2 + 1];
            ccr[c] = P_c_re[(g * 16 + c) * 64 + lane]; cci[c] = P_c_im[(g * 16 + c) * 64 + lane]; }
        for (int t = 0; t < 2048; ++t) {
            float bur = 0.f, bui = 0.f;
            float uown = 0.f;
#pragma unroll
            for (int c = 0; c < 16; ++c) {
                const float u = bf2f(up[t * 16 + c]);
                bur += bbr[c] * u; bui += bbi[c] * u;
                if ((lane & 15) == c) uown = u;
            }
            const float nr = lr * xr - li * xi + bur, ni = lr * xi + li * xr + bui;
            xr = nr; xi = ni;
            float yown = 0.f;
#pragma unroll
            for (int c = 0; c < 16; ++c) {
                const float v = ccr[c] * xr - cci[c] * xi;
                const float tot = wave_sum(v);
                if ((lane & 15) == c) yown = tot;
            }
            if (lane < 16) {
                const float y = yown + dsk * uown;
                P_GB[((size_t)b * 2048 + t) * 1024 + g * 16 + lane] = (bf16)f2bf(gelu_tanh_f(y));
            }
        }
    }
}

__device__ __forceinline__ void row_pass1(Frame& F, CArgs args) {
    const int gw = blockIdx.x * 8 + F.wave, NGW = F.G * 8, lane = lane_id();
    for (int m = gw; m < M; m += NGW) {
        const GAS f32x4* hr = (const GAS f32x4*)(P_H2 + (size_t)m * D) + lane; const GAS f32x4* xr = (const GAS f32x4*)(P_x + (size_t)m * D) + lane;
        const GAS f32x4* g1 = (const GAS f32x4*)P_attn_post + lane; const GAS f32x4* g2 = (const GAS f32x4*)P_ssm_pre + lane;
        f32x4 v[4]; float s = 0.f;
#pragma unroll
        for (int j = 0; j < 4; ++j) { v[j] = hr[64 * j]; s += (v[j].x * v[j].x + v[j].y * v[j].y) + (v[j].z * v[j].z + v[j].w * v[j].w); }
        const float rs = 1.f / sqrtf(wave_sum(s) * (1.f / D) + EPS);
        float s2 = 0.f;
#pragma unroll
        for (int j = 0; j < 4; ++j) { v[j] = xr[64 * j] + v[j] * rs * g1[64 * j]; s2 += (v[j].x * v[j].x + v[j].y * v[j].y) + (v[j].z * v[j].z + v[j].w * v[j].w); }
        const float rs2 = 1.f / sqrtf(wave_sum(s2) * (1.f / D) + EPS);
        GAS f32x4* o = (GAS f32x4*)(P_out + (size_t)m * D) + lane;
        GAS unsigned long long* o8 = (GAS unsigned long long*)(P_XN2 + (size_t)m * D) + lane;
#pragma unroll
        for (int j = 0; j < 4; ++j) { o[64 * j] = v[j]; const f32x4 g = g2[64 * j];
            o8[64 * j] = (unsigned long long)pk2(v[j].x * rs2 * g.x, v[j].y * rs2 * g.y) | ((unsigned long long)pk2(v[j].z * rs2 * g.z, v[j].w * rs2 * g.w) << 32); }
    }
}
__device__ __forceinline__ void row_pass2(Frame& F, CArgs args) {
    const int gw = blockIdx.x * 8 + F.wave, NGW = F.G * 8, lane = lane_id();
    for (int m = gw; m < M; m += NGW) {
        const GAS f32x4* hr = (const GAS f32x4*)(P_H3 + (size_t)m * D) + lane; GAS f32x4* o = (GAS f32x4*)(P_out + (size_t)m * D) + lane;
        const GAS f32x4* g1 = (const GAS f32x4*)P_ssm_post + lane;
        f32x4 v[4]; float s = 0.f;
#pragma unroll
        for (int j = 0; j < 4; ++j) { v[j] = hr[64 * j]; s += (v[j].x * v[j].x + v[j].y * v[j].y) + (v[j].z * v[j].z + v[j].w * v[j].w); }
        const float rs = 1.f / sqrtf(wave_sum(s) * (1.f / D) + EPS);
#pragma unroll
        for (int j = 0; j < 4; ++j) o[64 * j] = o[64 * j] + v[j] * rs * g1[64 * j];
    }
}

__global__ void __launch_bounds__(512, 2) mk_fwd(Args kargs_unused) {
    CArgs args = (CArgs)__builtin_amdgcn_kernarg_segment_ptr();
    extern __shared__ __attribute__((aligned(16))) unsigned char lds[];
    Frame F;
    F.lds = (LAS unsigned char*)lds;
    F.wave = __builtin_amdgcn_readfirstlane(threadIdx.x >> 6);
    F.G = gridDim.x;
    gu32* ctl = (gu32*)(args->ws + WS_CTL);
    volatile LAS unsigned* MISC = (volatile LAS unsigned*)(F.lds + MISC_OFF);
    for (int u = (F.wave * 64 + lane_id()); u < (LDS_BYTES - LDSCTL_OFF) / 4; u += 512) ((LAS unsigned*)(F.lds + LDSCTL_OFF))[u] = 0u;
    __syncthreads();
    XcdBarrier bar; bar.bar = (unsigned*)(ctl + CW_BAR); bar.x = 0; bar.st = nullptr;
    if (N_LAUNCHES == 1) bar = xcd_barrier_post((unsigned*)(ctl + CW_BAR), MISC + 8, F.wave);
    const int lo = args->ph_lo, hi = args->ph_hi; (void)lo; (void)hi;
#define OPQ() asm volatile("" : "+s"(args))
#if MK_N_LAUNCHES == 1
#define IN(k) true
#define SEAM(k) xcd_barrier(bar, F.wave)
#else
#define IN(k) (lo <= (k) && (k) < hi)
#define SEAM(k) do { if (IN(k) && IN((k) + 1)) xcd_barrier(bar, F.wave); } while (0)
#endif

    if (IN(0)) { OPQ(); p0_prologue(F, args); } SEAM(0);
    for (int half = 0; half < 2; ++half) {
        if (IN(1 + 2 * half)) { OPQ();
#if OPT_GEMM_IN
            pg8::ProbInProj P{P_XN + (size_t)half * HM * D, P_Wt_in, D}; pg8::StaticOrder S; S.init(HM, NIN, F.G, (int)blockIdx.x);
            pg8::EpiInProj E{P_Qh, P_Kh, P_VTh, P_SZh}; pg8::gemm_phase<pg8::EpiInProj, pg8::ProbInProj, true>(F.lds, F.wave, P, S, E);
#else
            EnInProj E{P_Qh, P_Kh, P_VTh, P_SZh}; naive_gemm(F, P_XN + (size_t)half * HM * D, P_Wt_in, HM, NIN, D, E);
#endif
        } SEAM(1 + 2 * half);
        if (IN(2 + 2 * half)) { OPQ();
#if OPT_ATTN
            att::attn_phase(F, args, half);
#else
            naive_attn(F, args, half);
#endif
        } SEAM(2 + 2 * half);
    }
    if (IN(5)) { OPQ();
#if OPT_GEMM_AO
        pg8::ProbPlain P{P_OG, P_Wt_ao, D}; pg8::StaticOrder S; S.init(M, D, F.G, (int)blockIdx.x);
        pg8::EpiF32 E{P_H2, D}; pg8::gemm_phase<pg8::EpiF32, pg8::ProbPlain, false>(F.lds, F.wave, P, S, E);
#else
        EnF32 E{P_H2}; naive_gemm(F, P_OG, P_Wt_ao, M, D, D, E);
#endif
    } SEAM(5);
    if (IN(6)) { OPQ(); row_pass1(F, args); } SEAM(6);
    if (IN(7)) { OPQ();
#if OPT_GEMM_SI
        pg8::ProbPlain P{P_XN2, P_Wt_si, D}; pg8::StaticOrder S; S.init(M, 2 * D, F.G, (int)blockIdx.x);
        pg8::EpiSsmIn E{P_UG, P_SZ2}; pg8::gemm_phase<pg8::EpiSsmIn, pg8::ProbPlain, true>(F.lds, F.wave, P, S, E);
#else
        EnSsmIn E{P_UG, P_SZ2}; naive_gemm(F, P_XN2, P_Wt_si, M, 2 * D, D, E);
#endif
    } SEAM(7);
    if (IN(8)) { OPQ(); naive_scan(F, args); } SEAM(8);
    if (IN(9)) { OPQ();
#if OPT_GEMM_GLU
        pg8::ProbPlain P{P_GB, P_Wt_glu, D}; pg8::StaticOrder S; S.init(M, D, F.G, (int)blockIdx.x);
        pg8::EpiGlu E{P_GB, P_SZ2, P_b_glu, P_Y2}; pg8::gemm_phase<pg8::EpiGlu, pg8::ProbPlain, false>(F.lds, F.wave, P, S, E);
#else
        EnGlu E{P_GB, P_SZ2, P_b_glu, P_Y2}; naive_gemm(F, P_GB, P_Wt_glu, M, D, D, E);
#endif
    } SEAM(9);
    if (IN(10)) { OPQ();
#if OPT_GEMM_SO
        pg8::ProbPlain P{P_Y2, P_Wt_so, D}; pg8::StaticOrder S; S.init(M, D, F.G, (int)blockIdx.x);
        pg8::EpiF32 E{P_H3, D}; pg8::gemm_phase<pg8::EpiF32, pg8::ProbPlain, false>(F.lds, F.wave, P, S, E);
#else
        EnF32 E{P_H3}; naive_gemm(F, P_Y2, P_Wt_so, M, D, D, E);
#endif
    } SEAM(10);
    if (IN(11)) { OPQ(); row_pass2(F, args); }
#undef IN
#undef SEAM
}

extern "C" void kernel_launch(void* const* d_in, const int* in_sizes, int n_in, void* d_out, int out_size, void* d_ws, size_t ws_size, hipStream_t stream) {
    static int grid = 0;
    if (grid == 0) {
        if (n_in != 20 || out_size != M * D || ws_size < WS_END) { fprintf(stderr, "kernel_launch: unexpected shapes n_in %d out %d ws %zu\n", n_in, out_size, ws_size); grid = -1; return; }
        int dev = 0, cus = 0, per_cu = 0;
        if (hipGetDevice(&dev) != hipSuccess || hipDeviceGetAttribute(&cus, hipDeviceAttributeMultiprocessorCount, dev) != hipSuccess) { grid = -1; return; }
        if (hipFuncSetAttribute((const void*)mk_fwd, hipFuncAttributeMaxDynamicSharedMemorySize, LDS_BYTES) != hipSuccess) { fprintf(stderr, "kernel_launch: hipFuncSetAttribute failed\n"); grid = -1; return; }
        if (hipOccupancyMaxActiveBlocksPerMultiprocessor(&per_cu, (const void*)mk_fwd, 512, LDS_BYTES) != hipSuccess || per_cu < 1) { fprintf(stderr, "kernel_launch: occupancy query says %d\n", per_cu); per_cu = 1; }
        (void)hipGetLastError();
        grid = cus;
    }
    if (grid < 0) return;
    (void)hipMemsetAsync((char*)d_ws + WS_CTL, 0, CTL_ZERO_BYTES, stream);
    Args a{};
    for (int i = 0; i < 20; ++i) a.in[i] = (const float*)d_in[i];
    a.out = (float*)d_out; a.ws = (unsigned char*)d_ws;
    for (int li = 0; li < N_LAUNCHES; ++li) {
        a.ph_lo = (N_LAUNCHES == 1) ? 0 : li; a.ph_hi = (N_LAUNCHES == 1) ? NPH : li + 1; a.li = li;
        hipLaunchKernelGGL(mk_fwd, dim3(grid), dim3(512), LDS_BYTES, stream, a);
    }
}
```

```cpp
#include <hip/hip_runtime.h>
#include <cstdio>
#include <cstdint>

#ifndef MK_N_LAUNCHES
#define MK_N_LAUNCHES 1
#endif
#define OPT_GEMM_IN 1
#define OPT_GEMM_AO 1
#define OPT_GEMM_SI 1
#define OPT_GEMM_GLU 1
#define OPT_GEMM_SO 1
#define OPT_ATTN 1
#define OPT_SCAN 1

#define GAS __attribute__((address_space(1)))
#define LAS __attribute__((address_space(3)))
typedef unsigned short bf16;
typedef short bf16x8 __attribute__((ext_vector_type(8)));
typedef float f32x4 __attribute__((ext_vector_type(4)));
typedef float f32x16 __attribute__((ext_vector_type(16)));
typedef unsigned u32x4 __attribute__((ext_vector_type(4)));
typedef unsigned u32x2 __attribute__((ext_vector_type(2)));
typedef GAS unsigned gu32;

constexpr int BATCH = 8, SEQ = 2048, D = 1024, M = BATCH * SEQ;
constexpr int NIN = 10240;
constexpr int HM = M / 2;
constexpr int NPH = 12;
constexpr int N_LAUNCHES = MK_N_LAUNCHES;
constexpr float EPS = 1e-6f;
constexpr float LOG2E = 1.4426950408889634f;
constexpr float C2 = 0.125f * LOG2E;

constexpr size_t MiB = 1u << 20;
constexpr size_t WS_CTL = 0, CTL_ZERO_BYTES = 1 * MiB;
constexpr size_t WS_WT_IN = 2 * MiB, WS_WT_AO = 22 * MiB, WS_WT_SI = 24 * MiB, WS_WT_GLU = 28 * MiB, WS_WT_SO = 30 * MiB;
constexpr size_t WS_W1 = 32 * MiB, WS_WY = 36 * MiB;
constexpr size_t WS_SMALL = 48 * MiB;
constexpr size_t WS_OG = 49 * MiB;
constexpr size_t WS_Q = 81 * MiB, WS_K = 129 * MiB, WS_VT = 177 * MiB, WS_SZ = 225 * MiB;
constexpr size_t WS_H2 = 81 * MiB;
constexpr size_t WS_XN2 = 145 * MiB, WS_UG = 177 * MiB, WS_SZ2 = 209 * MiB;
constexpr size_t WS_GB = 81 * MiB, WS_Y2 = 113 * MiB, WS_H3 = 145 * MiB;
constexpr size_t WS_END = 256 * MiB;
constexpr int SM_LAM = 0;
constexpr int SM_LAMT = SM_LAM + 64 * 64 * 2;
constexpr int SM_BBAR = SM_LAMT + 64 * 64 * 2;
constexpr int SM_BIAS = SM_BBAR + 64 * 64 * 16 * 2;
constexpr int SM_END = SM_BIAS + 3 * 16 * 192;
static_assert((size_t)SM_END * 4 <= 1 * MiB, "small tables");
constexpr int CW_BAR = 4096;

constexpr int RING_BYTES = 131072;
constexpr int LDSCTL_OFF = 139264, MISC_OFF = LDSCTL_OFF + 320;
constexpr int LDS_BYTES = 147456;

#define RLX_AGENT __ATOMIC_RELAXED, __HIP_MEMORY_SCOPE_AGENT
__device__ __forceinline__ int lane_id() { int l = (int)__builtin_amdgcn_mbcnt_hi(~0u, __builtin_amdgcn_mbcnt_lo(~0u, 0u)); asm volatile("" : "+v"(l)); return l; }
__device__ __forceinline__ unsigned f2bf(float f) { unsigned u = __builtin_bit_cast(unsigned, f); return (u + 0x7fffu + ((u >> 16) & 1u)) >> 16; }
__device__ __forceinline__ unsigned pk2(float lo, float hi) { return f2bf(lo) | (f2bf(hi) << 16); }
__device__ __forceinline__ float bf2f(bf16 b) { return __builtin_bit_cast(float, ((unsigned)b) << 16); }
__device__ __forceinline__ float silu_f(float z) { return z / (1.f + __expf(-z)); }
__device__ __forceinline__ float sigmoid_f(float z) { return 1.f / (1.f + __expf(-z)); }
__device__ __forceinline__ float gelu_tanh_f(float x) { const float u = 0.7978845608028654f * (x + 0.044715f * x * x * x); const float t = 1.f - 2.f / (__expf(2.f * u) + 1.f); return 0.5f * x * (1.f + t); }
__device__ __forceinline__ float wave_sum(float v) {
#pragma unroll
    for (int o = 1; o < 64; o <<= 1) v += __shfl_xor(v, o);
    return v;
}
__device__ __forceinline__ float wave_max(float v) {
#pragma unroll
    for (int o = 1; o < 64; o <<= 1) v = fmaxf(v, __shfl_xor(v, o));
    return v;
}

#define XB_TMO      128
#define XB_XCNT(j)  (256  + 64 * (j))
#define XB_XSUB(j)  (1280 + 64 * (j))
#define XB_XGEN(j)  (2304 + 64 * (j))
#define XB_TOP      3328
#define XB_TOPGEN   3392
#define XCD_BAR_WORDS 3456
#define XB_SPIN_CAP (1u << 22)
__device__ __forceinline__ unsigned xb_ld(unsigned* p)              { return __hip_atomic_load(p, __ATOMIC_RELAXED, __HIP_MEMORY_SCOPE_AGENT); }
__device__ __forceinline__ unsigned xb_add(unsigned* p, unsigned v) { return __hip_atomic_fetch_add(p, v, __ATOMIC_RELAXED, __HIP_MEMORY_SCOPE_AGENT); }
__device__ __forceinline__ unsigned xb_xcc_id() { return (unsigned)__builtin_amdgcn_s_getreg((3 << 11) | 20) & 0xFu; }
#define XB_SPIN(cond, bar) do { unsigned _sp = 0; while (cond) { __builtin_amdgcn_s_sleep(1); \
    if ((++_sp & 255u) == 0u) { if (xb_ld(&(bar)[XB_TMO])) break; if (_sp > XB_SPIN_CAP) { atomicAdd(&(bar)[XB_TMO], 1u); break; } } } } while (0)
struct XcdBarrier { unsigned* bar; unsigned x; volatile LAS unsigned* st; };
__device__ __forceinline__ XcdBarrier xcd_barrier_post(unsigned* bar, volatile LAS unsigned* st, int wave) {
    XcdBarrier b; b.bar = bar; b.x = xb_xcc_id(); b.st = st;
    if (wave == 0 && lane_id() == 0) (void)xb_add(&bar[XB_XCNT(b.x)], 1u);
    return b;
}
__device__ __forceinline__ void xcd_barrier_complete(unsigned* bar, unsigned x, unsigned& nloc, unsigned& nx) {
    const unsigned G = gridDim.x * gridDim.y * gridDim.z;
    unsigned sum, cnt, mine, sp = 0u;
    for (;;) {
        sum = 0u; cnt = 0u; mine = 0u;
#pragma unroll
        for (unsigned j = 0; j < 16; ++j) { const unsigned c = xb_ld(&bar[XB_XCNT(j)]); sum += c; cnt += (c > 0u) ? 1u : 0u; mine = (j == x) ? c : mine; }
        if (sum == G) break;
        __builtin_amdgcn_s_sleep(1);
        if ((++sp & 255u) == 0u) { if (xb_ld(&bar[XB_TMO])) break; if (sp > XB_SPIN_CAP) { atomicAdd(&bar[XB_TMO], 1u); break; } }
    }
    nloc = mine > 0u ? mine : 1u; nx = cnt > 0u ? cnt : 1u;
}
__device__ __forceinline__ void xcd_barrier(const XcdBarrier& b, int wave) {
    asm volatile("s_waitcnt vmcnt(0)" ::: "memory");
    __syncthreads();
    if (wave == 0 && lane_id() == 0) {
        unsigned* bar = b.bar;
        __builtin_amdgcn_s_waitcnt(0);
        unsigned nloc = b.st[0], nx = b.st[1];
        if (nloc == 0u) { xcd_barrier_complete(bar, b.x, nloc, nx); b.st[0] = nloc; b.st[1] = nx; }
        const unsigned old = xb_add(&bar[XB_XSUB(b.x)], 1u);
        const unsigned gen = old / nloc;
        if (old + 1u == (gen + 1u) * nloc) {
            __builtin_amdgcn_fence(__ATOMIC_RELEASE, "agent");
            asm volatile("s_waitcnt vmcnt(0)" ::: "memory");
            const unsigned og = xb_add(&bar[XB_TOP], 1u);
            const unsigned tg = og / nx;
            if (og + 1u == (tg + 1u) * nx) xb_add(&bar[XB_TOPGEN], 1u);
            else XB_SPIN(xb_ld(&bar[XB_TOPGEN]) == tg, bar);
            __builtin_amdgcn_fence(__ATOMIC_ACQUIRE, "agent");
            xb_add(&bar[XB_XGEN(b.x)], 1u);
            asm volatile("s_waitcnt vmcnt(0)" ::: "memory");
        } else {
            XB_SPIN(xb_ld(&bar[XB_XGEN(b.x)]) == gen, bar);
            __builtin_amdgcn_fence(__ATOMIC_ACQUIRE, "agent");
            asm volatile("s_waitcnt vmcnt(0)" ::: "memory");
        }
    }
    __syncthreads();
}

struct Args { const float* in[20]; float* out; unsigned char* ws; int ph_lo, ph_hi, li, pad; };
struct Frame {
    LAS unsigned char* lds;
    int wave, G;
};
typedef const __attribute__((address_space(4))) Args* CArgs;
#define IN_(i) (args->in[i])
#define P_x IN_(0)
#define P_rel_bias IN_(1)
#define P_attn_pre IN_(2)
#define P_attn_win IN_(3)
#define P_attn_wout IN_(4)
#define P_attn_post IN_(5)
#define P_ssm_pre IN_(6)
#define P_ssm_win IN_(7)
#define P_a_re IN_(8)
#define P_a_im IN_(9)
#define P_log_dt IN_(10)
#define P_b_re IN_(11)
#define P_b_im IN_(12)
#define P_c_re IN_(13)
#define P_c_im IN_(14)
#define P_dskip IN_(15)
#define P_w_glu IN_(16)
#define P_b_glu IN_(17)
#define P_ssm_wout IN_(18)
#define P_ssm_post IN_(19)
#define WSB(off) ((bf16*)(args->ws + (off)))
#define WSF(off) ((float*)(args->ws + (off)))
#define P_Wt_in WSB(WS_WT_IN)
#define P_Wt_ao WSB(WS_WT_AO)
#define P_Wt_si WSB(WS_WT_SI)
#define P_Wt_glu WSB(WS_WT_GLU)
#define P_Wt_so WSB(WS_WT_SO)
#define P_XN ((bf16*)args->out)
#define P_OG WSB(WS_OG)
#define P_Qh WSB(WS_Q)
#define P_Kh WSB(WS_K)
#define P_VTh WSB(WS_VT)
#define P_SZh WSB(WS_SZ)
#define P_XN2 WSB(WS_XN2)
#define P_UG WSB(WS_UG)
#define P_SZ2 WSB(WS_SZ2)
#define P_GB WSB(WS_GB)
#define P_Y2 WSB(WS_Y2)
#define P_H2 WSF(WS_H2)
#define P_H3 WSF(WS_H3)
#define P_small WSF(WS_SMALL)
#define P_out (args->out)


__device__ __forceinline__ void p0_transpose_item(const float* W, int K, int N, bf16* WT, LAS float* scr, int item, int lane) {
    const int nblk = N / 32, kb = item / nblk, nb = item % nblk, k0 = 64 * kb, n0 = 32 * nb;
#pragma unroll 8
    for (int i = 0; i < 32; ++i) { const int kk = 2 * i + (lane >> 5); scr[kk * 33 + (lane & 31)] = W[(size_t)(k0 + kk) * N + n0 + (lane & 31)]; }
    asm volatile("s_waitcnt lgkmcnt(0)" ::: "memory");
    const int c = lane & 7;
#pragma unroll
    for (int j = 0; j < 4; ++j) { const int n = (lane >> 3) + 8 * j; const LAS float* s = scr + (8 * c) * 33 + n;
        u32x4 o; o.x = pk2(s[0 * 33], s[1 * 33]); o.y = pk2(s[2 * 33], s[3 * 33]); o.z = pk2(s[4 * 33], s[5 * 33]); o.w = pk2(s[6 * 33], s[7 * 33]);
        *(GAS u32x4*)(WT + (size_t)(n0 + n) * K + k0 + 8 * c) = o; }
    asm volatile("s_waitcnt lgkmcnt(0)" ::: "memory");
}
__device__ __forceinline__ void rms_row_to_bf16(const float* xrow, const float* gain, bf16* orow, int lane) {
    const GAS f32x4* xr = (const GAS f32x4*)xrow + lane; const GAS f32x4* gr = (const GAS f32x4*)gain + lane;
    f32x4 v[4]; float s = 0.f;
#pragma unroll
    for (int j = 0; j < 4; ++j) { v[j] = xr[64 * j]; s += (v[j].x * v[j].x + v[j].y * v[j].y) + (v[j].z * v[j].z + v[j].w * v[j].w); }
    const float rs = 1.f / sqrtf(wave_sum(s) * (1.f / D) + EPS);
    GAS unsigned long long* o8 = (GAS unsigned long long*)orow + lane;
#pragma unroll
    for (int j = 0; j < 4; ++j) { const f32x4 g = gr[64 * j]; o8[64 * j] = (unsigned long long)pk2(v[j].x * rs * g.x, v[j].y * rs * g.y) | ((unsigned long long)pk2(v[j].z * rs * g.z, v[j].w * rs * g.w) << 32); }
}
__device__ __forceinline__ int t5_bucket(int dist) {
    const int n = dist < 1 ? 1 : dist;
    int large = 16 + (int)(logf((float)n / 16.f) / 4.852030263919617f * 16.f);
    large = large < 31 ? large : 31;
    return dist < 16 ? dist : large;
}
__device__ __forceinline__ void p0_prologue(Frame& F, CArgs args) {
    LAS float* scr = (LAS float*)(F.lds + F.wave * 16384);
    const int gw = blockIdx.x * 8 + F.wave, NGW = F.G * 8;
    constexpr int I_IN = (D / 64) * (NIN / 32), I_AO = (D / 64) * (D / 32), I_SI = (D / 64) * (2 * D / 32);
    constexpr int NITEMS = I_IN + I_AO + I_SI + I_AO + I_AO;
    for (int it = gw; it < NITEMS; it += NGW) {
        int r = it;
        if (r < I_IN) { p0_transpose_item(P_attn_win, D, NIN, P_Wt_in, scr, r, lane_id()); continue; } r -= I_IN;
        if (r < I_AO) { p0_transpose_item(P_attn_wout, D, D, P_Wt_ao, scr, r, lane_id()); continue; } r -= I_AO;
        if (r < I_SI) { p0_transpose_item(P_ssm_win, D, 2 * D, P_Wt_si, scr, r, lane_id()); continue; } r -= I_SI;
        if (r < I_AO) { p0_transpose_item(P_w_glu, D, D, P_Wt_glu, scr, r, lane_id()); continue; } r -= I_AO;
        p0_transpose_item(P_ssm_wout, D, D, P_Wt_so, scr, r, lane_id());
    }
    for (int m = gw; m < M; m += NGW) rms_row_to_bf16(P_x + (size_t)m * D, P_attn_pre, P_XN + (size_t)m * D, lane_id());
    const int gt = blockIdx.x * 512 + (F.wave * 64 + lane_id()), NGT = F.G * 512;
    for (int i = gt; i < 64 * 64; i += NGT) {
        const int g = i >> 6;
        const float are = P_a_re[i], aim = P_a_im[i], dt = __expf(P_log_dt[g]);
        const float xr = are * dt, yi = aim * dt;
        float sn, cs; sincosf(yi, &sn, &cs);
        const float ex = expf(xr);
        P_small[SM_LAM + 2 * i] = ex * cs; P_small[SM_LAM + 2 * i + 1] = ex * sn;
        float sn16, cs16; sincosf(16.f * yi, &sn16, &cs16); const float ex16 = expf(16.f * xr);
        P_small[SM_LAMT + 2 * i] = ex16 * cs16; P_small[SM_LAMT + 2 * i + 1] = ex16 * sn16;
        const float sh = sinf(0.5f * yi);
        const float nr = expm1f(xr) * cs - 2.f * sh * sh, ni = ex * sn;
        const float den = are * are + aim * aim;
        const float fr = (nr * are + ni * aim) / den, fi = (ni * are - nr * aim) / den;
        for (int c = 0; c < 16; ++c) {
            const float br = P_b_re[i * 16 + c], bi = P_b_im[i * 16 + c];
            P_small[SM_BBAR + (i * 16 + c) * 2] = fr * br - fi * bi;
            P_small[SM_BBAR + (i * 16 + c) * 2 + 1] = fr * bi + fi * br;
        }
    }
    for (int i = gt; i < 3 * 16 * 192; i += NGT) {
        const int dist = i % 192, hh = (i / 192) & 15, g = i / (192 * 16);
        float v = -1e30f;
        if (dist <= 128) v = P_rel_bias[t5_bucket(dist << (2 * g)) * 16 + hh] * LOG2E;
        P_small[SM_BIAS + i] = v;
    }
    {
        const int tid = F.wave * 64 + lane_id();
        LAS float* lam = (LAS float*)F.lds;
        LAS float* bb = lam + 17 * 64 * 2;
        LAS float* cc = bb + 64 * 16 * 2;
        LAS float* kt = cc + 16 * 64 * 2;
        LAS float* ff = kt + 4096;
        for (int g = blockIdx.x; g < 64; g += F.G) {
            __syncthreads();
            const float dt = __expf(P_log_dt[g]);
            for (int i = tid; i < 17 * 64; i += 512) { const int l = i >> 6, p = i & 63; const float are = P_a_re[g * 64 + p], aim = P_a_im[g * 64 + p];
                float sn, cs; sincosf((float)l * (aim * dt), &sn, &cs); const float ex = expf((float)l * (are * dt)); lam[2 * i] = ex * cs; lam[2 * i + 1] = ex * sn; }
            if (tid < 64) { const float are = P_a_re[g * 64 + tid], aim = P_a_im[g * 64 + tid]; const float xr = are * dt, yi = aim * dt; float sn, cs; sincosf(yi, &sn, &cs);
                const float ex = expf(xr), sh = sinf(0.5f * yi), nr = expm1f(xr) * cs - 2.f * sh * sh, ni = ex * sn, den = are * are + aim * aim;
                ff[2 * tid] = (nr * are + ni * aim) / den; ff[2 * tid + 1] = (ni * are - nr * aim) / den; }
            for (int i = tid; i < 16 * 64; i += 512) { const int c = i >> 6, p = i & 63; cc[2 * i] = P_c_re[(g * 16 + c) * 64 + p]; cc[2 * i + 1] = P_c_im[(g * 16 + c) * 64 + p]; }
            __syncthreads();
            for (int i = tid; i < 64 * 16; i += 512) { const int p = i >> 4; const float br = P_b_re[g * 1024 + i], bi = P_b_im[g * 1024 + i], fr = ff[2 * p], fi = ff[2 * p + 1];
                bb[2 * i] = fr * br - fi * bi; bb[2 * i + 1] = fr * bi + fi * br; }
            __syncthreads();
            for (int i = tid; i < 4096; i += 512) { const int l = i >> 8, co = (i >> 4) & 15, ci = i & 15; float acc = 0.f;
                for (int p = 0; p < 64; ++p) { const float cr = cc[2 * (co * 64 + p)], cim = cc[2 * (co * 64 + p) + 1], lr = lam[2 * (l * 64 + p)], li = lam[2 * (l * 64 + p) + 1], br = bb[2 * (p * 16 + ci)], bi = bb[2 * (p * 16 + ci) + 1];
                    acc += cr * (lr * br - li * bi) - cim * (lr * bi + li * br); }
                if (l == 0 && co == ci) acc += P_dskip[g * 16 + co];
                kt[i] = acc; }
            __syncthreads();
            bf16* W1 = WSB(WS_W1) + (size_t)g * 128 * 256; bf16* WY = WSB(WS_WY) + (size_t)g * 256 * 384;
            for (int rr = tid; rr < 128 * 32; rr += 512) { const int n = rr >> 5, k0 = (rr & 31) * 8, s_ = k0 >> 4, c0 = k0 & 15, p = n & 63, im = n >> 6;
                const float lr = lam[2 * ((15 - s_) * 64 + p)], li = lam[2 * ((15 - s_) * 64 + p) + 1]; float v[8];
#pragma unroll
                for (int e = 0; e < 8; ++e) { const float br = bb[2 * (p * 16 + c0 + e)], bi = bb[2 * (p * 16 + c0 + e) + 1]; v[e] = im ? (lr * bi + li * br) : (lr * br - li * bi); }
                u32x4 o; o.x = pk2(v[0], v[1]); o.y = pk2(v[2], v[3]); o.z = pk2(v[4], v[5]); o.w = pk2(v[6], v[7]); *(GAS u32x4*)(W1 + (size_t)n * 256 + k0) = o; }
            for (int rr = tid; rr < 256 * 48; rr += 512) { const int n = rr / 48, k0 = (rr % 48) * 8, tau = n >> 4, co = n & 15; float v[8];
                if (k0 < 256) { const int s_ = k0 >> 4, ci0 = k0 & 15;
#pragma unroll
                    for (int e = 0; e < 8; ++e) v[e] = (tau >= s_) ? kt[((tau - s_) * 16 + co) * 16 + ci0 + e] : 0.f;
                } else {
#pragma unroll
                    for (int e = 0; e < 8; ++e) { const int kk = k0 - 256 + e, p = kk & 63, im = kk >> 6;
                        const float cr = cc[2 * (co * 64 + p)], cim = cc[2 * (co * 64 + p) + 1], lr = lam[2 * ((tau + 1) * 64 + p)], li = lam[2 * ((tau + 1) * 64 + p) + 1];
                        v[e] = im ? -(cr * li + cim * lr) : (cr * lr - cim * li); } }
                u32x4 o; o.x = pk2(v[0], v[1]); o.y = pk2(v[2], v[3]); o.z = pk2(v[4], v[5]); o.w = pk2(v[6], v[7]); *(GAS u32x4*)(WY + (size_t)n * 384 + k0) = o; }
        }
    }
}

template <class Epi> __device__ __forceinline__ void naive_gemm(Frame& F, const bf16* A, const bf16* Bt, int Mrows, int N, int K, const Epi& epi) {
    const int ntn = N / 32, nt = (Mrows / 32) * ntn;
    const int gw = blockIdx.x * 8 + F.wave, NGW = F.G * 8;
    const int r32 = lane_id() & 31, hi = lane_id() >> 5;
    for (int tile = gw; tile < nt; tile += NGW) {
        const int tm = tile / ntn, tn = tile % ntn;
        f32x16 acc = {};
        const bf16* ap = A + (size_t)(tm * 32 + r32) * K + hi * 8;
        const bf16* bp = Bt + (size_t)(tn * 32 + r32) * K + hi * 8;
#pragma unroll 4
        for (int k = 0; k < K; k += 16) {
            const bf16x8 a = *(const GAS bf16x8*)(ap + k); const bf16x8 b = *(const GAS bf16x8*)(bp + k);
            acc = __builtin_amdgcn_mfma_f32_32x32x16_bf16(a, b, acc, 0, 0, 0);
        }
#pragma unroll
        for (int r = 0; r < 16; ++r) epi(tm * 32 + (r & 3) + 8 * (r >> 2) + 4 * hi, tn * 32 + r32, acc[r]);
    }
}
struct EnInProj {
    bf16 *Qh, *Kh, *VTh, *SZh;
    __device__ __forceinline__ void operator()(int m, int n, float v) const {
        const int bl = m >> 11, t = m & 2047;
        if (n < 9216) {
            const int tq = n / 3072, rem = n % 3072, g = rem >> 10, hh = (rem >> 6) & 15, e = rem & 63, sh = 2 * g;
            const int row = (t & ((1 << sh) - 1)) * (2048 >> sh) + (t >> sh);
            const size_t hb = (size_t)((bl * 3 + g) * 16 + hh);
            if (tq == 0) Qh[(hb * 2048 + row) * 64 + e] = (bf16)f2bf(v * C2);
            else if (tq == 1) Kh[(hb * 2048 + row) * 64 + e] = (bf16)f2bf(v);
            else VTh[(hb * 64 + e) * 2048 + row] = (bf16)f2bf(v);
        } else SZh[(size_t)m * 1024 + (n - 9216)] = (bf16)f2bf(silu_f(v));
    }
};
struct EnF32 { float* out; __device__ __forceinline__ void operator()(int m, int n, float v) const { out[(size_t)m * 1024 + n] = v; } };
struct EnSsmIn {
    bf16 *UG, *SZ2;
    __device__ __forceinline__ void operator()(int m, int n, float v) const {
        if (n < 1024) { const int g = n >> 4, c = n & 15, b = m >> 11, t = m & 2047; UG[((size_t)(b * 64 + g) * 2048 + t) * 16 + c] = (bf16)f2bf(v); }
        else SZ2[(size_t)m * 1024 + (n - 1024)] = (bf16)f2bf(silu_f(v));
    }
};
struct EnGlu {
    const bf16 *GB, *SZ2; const float* bglu; bf16* Y2;
    __device__ __forceinline__ void operator()(int m, int n, float v) const {
        const size_t o = (size_t)m * 1024 + n; const float gv = bf2f(GB[o]);
        Y2[o] = (bf16)f2bf(gv * sigmoid_f(v + bglu[n]) * bf2f(SZ2[o]));
    }
};

namespace pg8 {
constexpr int BM = 256, BK = 64, HALF = 128, HTB = HALF * BK * 2, STAGE_BYTES = 8 * HTB, NXCD = 8, WGM = 8;
__host__ __device__ __forceinline__ int lds_byte(int r, int c) { const int st = (r >> 4) * 2 + (c >> 5), rr = r & 15, cc = c & 31, ob = rr * 64 + cc * 2; return st * 1024 + (ob ^ (((ob >> 9) & 1) << 5)); }
__host__ __device__ __forceinline__ void stage_rc(int b, int& R, int& C) { const int st = b / 1024, sb = b % 1024, swz = sb ^ (((sb >> 9) & 1) << 5); R = (st >> 1) * 16 + swz / 64; C = (st & 1) * 32 + (swz % 64) / 2; }
__host__ __device__ __forceinline__ int perm32(int rho) { const int n = rho >> 4, i = rho & 15; return 8 * (i >> 2) + 4 * n + (i & 3); }
struct Unit { int pm, pn; };
struct StaticOrder {
    int nM, nN, nwg, G, c;
    __host__ __device__ void init(int M_, int N_, int G_, int c_) { nM = M_ / BM; nN = N_ / BM; nwg = nM * nN; G = G_; c = c_; }
    __host__ __device__ bool next(int i, Unit& u) const {
        const long L = (long)i * G + c; if (L >= nwg) return false;
        int wgid = (int)L; { const int q = nwg / NXCD, r = nwg % NXCD, xcd = wgid % NXCD, off = wgid / NXCD; wgid = (xcd < r ? xcd * (q + 1) : r * (q + 1) + (xcd - r) * q) + off; }
        const int nig = WGM * nN, gid = wgid / nig, fm = gid * WGM, gsz = (nM - fm) < WGM ? (nM - fm) : WGM;
        u.pm = fm + ((wgid % nig) % gsz); u.pn = (wgid % nig) / gsz; return true;
    }
};
__device__ __forceinline__ unsigned cvt_pk_bf16(float lo, float hi) { unsigned r; asm volatile("v_cvt_pk_bf16_f32 %0, %1, %2" : "=v"(r) : "v"(lo), "v"(hi)); return r; }
__device__ __forceinline__ u32x4 pack8(const f32x4& v0, const f32x4& v1) { u32x4 w; w.x = cvt_pk_bf16(v0[0], v0[1]); w.y = cvt_pk_bf16(v0[2], v0[3]); w.z = cvt_pk_bf16(v1[0], v1[1]); w.w = cvt_pk_bf16(v1[2], v1[3]); return w; }

struct ProbPlain {
    const bf16* A; const bf16* Bt; int K;
    static constexpr int NKIND = 1;
    __device__ __forceinline__ void operands(const Unit& u, const char*& cA, const char*& cB, int& kind) const {
        cA = (const char*)A + (size_t)u.pm * 256 * K * 2; cB = (const char*)Bt + (size_t)u.pn * 256 * K * 2; kind = 0; }
    __device__ __forceinline__ int brow(int kind, int cl) const { return cl; }
};
struct ProbInProj {
    const bf16* A; const bf16* Bt; int K;
    static constexpr int NKIND = 3;
    __device__ __forceinline__ void operands(const Unit& u, const char*& cA, const char*& cB, int& kind) const {
        const char* a = (const char*)A + (size_t)u.pm * 256 * K * 2; const char* b = (const char*)Bt + (size_t)u.pn * 256 * K * 2;
        const bool sw = (u.pn >= 24 && u.pn < 36);
        cA = sw ? b : a; cB = sw ? a : b; kind = sw ? ((u.pn - 24) >> 2) : 0; }
    __device__ __forceinline__ int brow(int kind, int cl) const { return kind == 0 ? cl : (kind == 1 ? 4 * (cl & 31) + (cl >> 5) : 16 * (cl & 7) + (cl >> 3)); }
};

struct EpiF32 {
    static constexpr bool PERM = false;
    float* C; int ldc;
    __device__ __forceinline__ void operator()(const f32x4 (&acc)[2][2][4][2], const Unit& u, int wr, int wc, int fr, int fq) const {
        const int row0 = u.pm * BM + wr * 64 + fr, col0 = u.pn * BM + wc * 32 + 4 * fq;
#pragma unroll
        for (int ai = 0; ai < 2; ++ai)
#pragma unroll
            for (int m = 0; m < 4; ++m) { float* rowp = C + (size_t)(row0 + ai * HALF + m * 16) * ldc + col0;
#pragma unroll
                for (int bj = 0; bj < 2; ++bj)
#pragma unroll
                    for (int n = 0; n < 2; ++n) *(f32x4*)(rowp + bj * HALF + n * 16) = acc[ai][bj][m][n]; }
    }
};
struct EpiInProj {
    static constexpr bool PERM = true;
    bf16 *Qh, *Kh, *VTh, *SZh;
    __device__ __forceinline__ void operator()(const f32x4 (&acc)[2][2][4][2], const Unit& u, int wr, int wc, int fr, int fq) const {
        if (u.pn < 24) {
            const int tq = u.pn >= 12 ? 1 : 0, pnn = u.pn - 12 * tq, g = pnn >> 2, sh = 2 * g, hq = (pnn & 3) * 4;
            const float sc = tq ? 1.f : C2; bf16* base = tq ? Kh : Qh;
#pragma unroll
            for (int ai = 0; ai < 2; ++ai)
#pragma unroll
                for (int m = 0; m < 4; ++m) {
                    const int rowl = u.pm * BM + ai * HALF + wr * 64 + m * 16 + fr, bl = rowl >> 11, t = rowl & 2047;
                    const int row = (t & ((1 << sh) - 1)) * (2048 >> sh) + (t >> sh);
#pragma unroll
                    for (int bj = 0; bj < 2; ++bj) { const int c8 = bj * HALF + wc * 32 + 8 * fq, hh = hq + (c8 >> 6), e0 = c8 & 63;
                        bf16* dst = base + ((size_t)((bl * 3 + g) * 16 + hh) * 2048 + row) * 64 + e0;
                        *(u32x4*)dst = pack8(acc[ai][bj][m][0] * sc, acc[ai][bj][m][1] * sc); } }
        } else if (u.pn < 36) {
            const int pv = u.pn - 24, g = pv >> 2, hq = (pv & 3) * 4, bl = u.pm >> 3, t0 = (u.pm & 7) * 256;
#pragma unroll
            for (int ai = 0; ai < 2; ++ai)
#pragma unroll
                for (int m = 0; m < 4; ++m) {
                    const int r = ai * HALF + wr * 64 + m * 16 + fr, hh = hq + (r >> 6), e = r & 63;
                    bf16* rowp = VTh + ((size_t)((bl * 3 + g) * 16 + hh) * 64 + e) * 2048;
#pragma unroll
                    for (int bj = 0; bj < 2; ++bj) { const int th = t0 + HALF * bj;
                        const int pos = g == 0 ? th + 32 * wc + 8 * fq : (g == 1 ? wc * 512 + (th >> 2) + 8 * fq : (4 * wc + fq) * 128 + (th >> 4));
                        *(u32x4*)(rowp + pos) = pack8(acc[ai][bj][m][0], acc[ai][bj][m][1]); } }
        } else {
#pragma unroll
            for (int ai = 0; ai < 2; ++ai)
#pragma unroll
                for (int m = 0; m < 4; ++m) {
                    const int rowl = u.pm * BM + ai * HALF + wr * 64 + m * 16 + fr;
#pragma unroll
                    for (int bj = 0; bj < 2; ++bj) { const int col = (u.pn - 36) * BM + bj * HALF + wc * 32 + 8 * fq;
                        f32x4 v0 = acc[ai][bj][m][0], v1 = acc[ai][bj][m][1];
#pragma unroll
                        for (int j = 0; j < 4; ++j) { v0[j] = silu_f(v0[j]); v1[j] = silu_f(v1[j]); }
                        *(u32x4*)(SZh + (size_t)rowl * 1024 + col) = pack8(v0, v1); } }
        }
    }
};
struct EpiSsmIn {
    static constexpr bool PERM = true;
    bf16 *UG, *SZ2;
    __device__ __forceinline__ void operator()(const f32x4 (&acc)[2][2][4][2], const Unit& u, int wr, int wc, int fr, int fq) const {
#pragma unroll
        for (int ai = 0; ai < 2; ++ai)
#pragma unroll
            for (int m = 0; m < 4; ++m) {
                const int row = u.pm * BM + ai * HALF + wr * 64 + m * 16 + fr, b = row >> 11, t = row & 2047;
#pragma unroll
                for (int bj = 0; bj < 2; ++bj) { const int col = u.pn * BM + bj * HALF + wc * 32 + 8 * fq;
                    f32x4 v0 = acc[ai][bj][m][0], v1 = acc[ai][bj][m][1];
                    if (u.pn < 4) { const int g = col >> 4, c0 = col & 15; *(u32x4*)(UG + ((size_t)(b * 64 + g) * 2048 + t) * 16 + c0) = pack8(v0, v1); }
                    else {
#pragma unroll
                        for (int j = 0; j < 4; ++j) { v0[j] = silu_f(v0[j]); v1[j] = silu_f(v1[j]); }
                        *(u32x4*)(SZ2 + (size_t)row * 1024 + (col - 1024)) = pack8(v0, v1); } } }
    }
};
struct EpiGlu {
    static constexpr bool PERM = true;
    const bf16 *GB, *SZ2; const float* bglu; bf16* Y2;
    __device__ __forceinline__ void operator()(const f32x4 (&acc)[2][2][4][2], const Unit& u, int wr, int wc, int fr, int fq) const {
#pragma unroll
        for (int ai = 0; ai < 2; ++ai)
#pragma unroll
            for (int m = 0; m < 4; ++m) {
                const int row = u.pm * BM + ai * HALF + wr * 64 + m * 16 + fr;
#pragma unroll
                for (int bj = 0; bj < 2; ++bj) { const int col = u.pn * BM + bj * HALF + wc * 32 + 8 * fq; const size_t o = (size_t)row * 1024 + col;
                    const u32x4 gq = *(const u32x4*)(GB + o), sq = *(const u32x4*)(SZ2 + o);
                    const f32x4 b0 = *(const f32x4*)(bglu + col), b1 = *(const f32x4*)(bglu + col + 4);
                    f32x4 v0 = acc[ai][bj][m][0] + b0, v1 = acc[ai][bj][m][1] + b1;
#pragma unroll
                    for (int j = 0; j < 4; ++j) {
                        const unsigned gw0 = gq[j >> 1], sw0 = sq[j >> 1], gw1 = gq[2 + (j >> 1)], sw1 = sq[2 + (j >> 1)];
                        const float g0 = __builtin_bit_cast(float, (j & 1) ? (gw0 & 0xffff0000u) : (gw0 << 16)), s0 = __builtin_bit_cast(float, (j & 1) ? (sw0 & 0xffff0000u) : (sw0 << 16));
                        const float g1 = __builtin_bit_cast(float, (j & 1) ? (gw1 & 0xffff0000u) : (gw1 << 16)), s1 = __builtin_bit_cast(float, (j & 1) ? (sw1 & 0xffff0000u) : (sw1 << 16));
                        v0[j] = g0 * sigmoid_f(v0[j]) * s0; v1[j] = g1 * sigmoid_f(v1[j]) * s1; }
                    *(u32x4*)(Y2 + o) = pack8(v0, v1); } }
    }
};

template <class Epi, class Prob, bool ALIGN_EPI>
__device__ __forceinline__ void gemm_phase(LAS unsigned char* lds, int wave_id, const Prob P, const StaticOrder& S, const Epi& E) {
    int lane_ = lane_id(); asm volatile("" : "+v"(lane_));
    const int wid = wave_id, lane = lane_, tid = wid * 64 + lane, wr = wid >> 2, wc = wid & 3, fr = lane & 15, fq = lane >> 4;
    const int K = P.K, nt = K / BK;
    unsigned voffA[2], voffB[2];
#pragma unroll
    for (int i = 0; i < 2; ++i) { int R, C; stage_rc(tid * 16 + i * 8192, R, C); voffA[i] = (unsigned)(R * K + C) * 2u; }
#define PG8_SET_VOFFB(kind_) do { int l2_ = lane_id(); asm volatile("" : "+v"(l2_)); const int t2_ = wid * 64 + l2_; _Pragma("unroll") for (int i = 0; i < 2; ++i) { int R, C; stage_rc(t2_ * 16 + i * 8192, R, C); \
        const int cl = Epi::PERM ? ((R & ~31) + perm32(R & 31)) : R; voffB[i] = (unsigned)(P.brow((kind_), cl) * K + C) * 2u; } } while (0)
    const size_t kstep = (size_t)(BK * 2);
    const size_t hstep = (size_t)HALF * K * 2;
    const unsigned ldsw = (unsigned)wid * 1024u;
    const int aoff = lds_byte(wr * 64 + fr, fq * 8), boff = lds_byte(wc * 32 + fr, fq * 8);
#define PG8_SA(b, h) (((b) * 2 + (h)) * HTB)
#define PG8_SB(b, h) ((4 + (b) * 2 + (h)) * HTB)
#define PG8_STAGE(bufoff, gbase, voff) do { _Pragma("unroll") for (int _i = 0; _i < 2; ++_i) \
        __builtin_amdgcn_global_load_lds((const unsigned*)((const char*)(gbase) + (voff)[_i]), (LAS unsigned*)(lds + (bufoff) + ldsw + _i * 8192), 16, 0, 0); } while (0)
#define PG8_LDA(dst, b, h) do { _Pragma("unroll") for (int m = 0; m < 4; ++m) _Pragma("unroll") for (int k = 0; k < 2; ++k) dst[m][k] = *(const LAS bf16x8*)(lds + PG8_SA(b, h) + aoff + m * 2048 + k * 1024); } while (0)
#define PG8_LDB(dst, b, h) do { _Pragma("unroll") for (int n = 0; n < 2; ++n) _Pragma("unroll") for (int k = 0; k < 2; ++k) dst[n][k] = *(const LAS bf16x8*)(lds + PG8_SB(b, h) + boff + n * 2048 + k * 1024); } while (0)
#define PG8_MMA(ai, bj, At, Bt) do { __builtin_amdgcn_s_setprio(1); _Pragma("unroll") for (int m = 0; m < 4; ++m) _Pragma("unroll") for (int n = 0; n < 2; ++n) _Pragma("unroll") for (int k = 0; k < 2; ++k) \
        acc[ai][bj][m][n] = __builtin_amdgcn_mfma_f32_16x16x32_bf16(Bt[n][k], At[m][k], acc[ai][bj][m][n], 0, 0, 0); __builtin_amdgcn_s_setprio(0); } while (0)
#define PG8_WAIT_V(n) asm volatile("s_waitcnt vmcnt(" #n ")" ::: "memory")
#define PG8_WAIT_L(n) asm volatile("s_waitcnt lgkmcnt(" #n ")" ::: "memory")
#define PG8_BAR __builtin_amdgcn_s_barrier()
#define PG8_SCHED __builtin_amdgcn_sched_barrier(0)
    Unit cur, nxt; int ui = 0;
    if (!S.next(0, cur)) return;
    f32x4 acc[2][2][4][2];
#pragma unroll
    for (int a = 0; a < 2; ++a)
#pragma unroll
        for (int b = 0; b < 2; ++b)
#pragma unroll
            for (int m = 0; m < 4; ++m)
#pragma unroll
                for (int n = 0; n < 2; ++n) acc[a][b][m][n] = (f32x4){0.f, 0.f, 0.f, 0.f};
    bf16x8 At[4][2], B0[2][2], B1[2][2];
    const char *cA, *cB; int ckind; P.operands(cur, cA, cB, ckind);
    PG8_SET_VOFFB(ckind);
    PG8_STAGE(PG8_SB(0, 0), cB, voffB); PG8_STAGE(PG8_SB(0, 1), cB + hstep, voffB); PG8_STAGE(PG8_SA(0, 0), cA, voffA); PG8_STAGE(PG8_SA(0, 1), cA + hstep, voffA);
    if (wr == 1) PG8_BAR;
    PG8_WAIT_V(2); PG8_BAR;
    PG8_STAGE(PG8_SB(1, 0), cB + kstep, voffB); PG8_STAGE(PG8_SA(1, 0), cA + kstep, voffA); PG8_STAGE(PG8_SB(1, 1), cB + hstep + kstep, voffB);
    PG8_WAIT_V(6); PG8_BAR;
    for (;;) {
        const bool has_next = S.next(ui + 1, nxt);
        const char *nA = cA, *nB = cB; int nkind = ckind;
        if (has_next) P.operands(nxt, nA, nB, nkind);
        for (int t = 0; t < nt; t += 2) {
            const bool last = (t == nt - 2);
            const char* a1 = cA + (size_t)(t + 1) * kstep;
            const char* a2 = last ? nA : cA + (size_t)(t + 2) * kstep; const char* b2 = last ? nB : cB + (size_t)(t + 2) * kstep;
            const char* a3 = a2 + kstep; const char* b3 = b2 + kstep;
            if (Prob::NKIND > 1 && last && nkind != ckind) PG8_SET_VOFFB(nkind);
            PG8_LDB(B0, 0, 0); PG8_LDB(B1, 0, 1); PG8_SCHED; PG8_LDA(At, 0, 0); PG8_STAGE(PG8_SA(1, 1), a1 + hstep, voffA);
            PG8_WAIT_V(8); PG8_WAIT_L(0); PG8_BAR; PG8_MMA(0, 0, At, B0); PG8_MMA(0, 1, At, B1); PG8_BAR; PG8_SCHED;
            PG8_LDA(At, 0, 1); PG8_STAGE(PG8_SB(0, 0), b2, voffB); PG8_STAGE(PG8_SB(0, 1), b2 + hstep, voffB); PG8_STAGE(PG8_SA(0, 0), a2, voffA);
            PG8_WAIT_V(8); PG8_WAIT_L(0); PG8_BAR; PG8_MMA(1, 0, At, B0); PG8_MMA(1, 1, At, B1); PG8_BAR; PG8_SCHED;
            PG8_LDB(B0, 1, 0); PG8_LDB(B1, 1, 1); PG8_SCHED; PG8_LDA(At, 1, 0); PG8_STAGE(PG8_SA(0, 1), a2 + hstep, voffA);
            PG8_WAIT_V(8); PG8_WAIT_L(0); PG8_BAR; PG8_MMA(0, 0, At, B0); PG8_MMA(0, 1, At, B1); PG8_BAR; PG8_SCHED;
            PG8_LDA(At, 1, 1); PG8_STAGE(PG8_SB(1, 0), b3, voffB); PG8_STAGE(PG8_SB(1, 1), b3 + hstep, voffB); PG8_STAGE(PG8_SA(1, 0), a3, voffA);
            PG8_WAIT_V(8); PG8_WAIT_L(0); PG8_BAR; PG8_MMA(1, 0, At, B0); PG8_MMA(1, 1, At, B1); PG8_BAR; PG8_SCHED;
        }
        if constexpr (ALIGN_EPI) { if (wr == 0) PG8_BAR; }
        E(acc, cur, wr, wc, fr, fq);
        if (!has_next) break;
#pragma unroll
        for (int a = 0; a < 2; ++a)
#pragma unroll
            for (int b = 0; b < 2; ++b)
#pragma unroll
                for (int m = 0; m < 4; ++m)
#pragma unroll
                    for (int n = 0; n < 2; ++n) acc[a][b][m][n] = (f32x4){0.f, 0.f, 0.f, 0.f};
        cur = nxt; cA = nA; cB = nB; ckind = nkind; ++ui;
        if constexpr (ALIGN_EPI) { if (wr == 1) PG8_BAR; }
    }
    PG8_WAIT_V(0);
    if constexpr (!ALIGN_EPI) { if (wr == 0) PG8_BAR; }
    PG8_BAR;
#undef PG8_SET_VOFFB
#undef PG8_SA
#undef PG8_SB
#undef PG8_STAGE
#undef PG8_LDA
#undef PG8_LDB
#undef PG8_MMA
#undef PG8_WAIT_V
#undef PG8_WAIT_L
#undef PG8_BAR
#undef PG8_SCHED
}
}

namespace att {
constexpr int AT_OL = 0, AT_LSE = 131072, AT_TAB = 135168;
constexpr float NEGV = -1e30f;
__device__ __forceinline__ int swap23(int i) { return (i & ~12) | ((i & 4) << 1) | ((i & 8) >> 1); }
__device__ __forceinline__ float swapmax(float m) { return fmaxf(m, __shfl_xor(m, 32)); }
__device__ __forceinline__ float swapsum(float m) { return m + __shfl_xor(m, 32); }
typedef float f32x2_t __attribute__((ext_vector_type(2))); typedef __bf16 bf16x2_t __attribute__((ext_vector_type(2)));
__device__ __forceinline__ unsigned cvtpk(float lo, float hi) { f32x2_t v = {lo, hi}; bf16x2_t b = __builtin_convertvector(v, bf16x2_t); return __builtin_bit_cast(unsigned, b); }
__device__ __forceinline__ int olds_off(int row, int col8) { return row * 128 + ((col8 ^ ((row ^ (row >> 4)) & 15)) << 3); }

__device__ __forceinline__ void task(const bf16* Qp, const bf16* Kp, const bf16* Vp, int m0, const LAS float* tab, int lane, f32x16& o0, f32x16& o1, float& mrow, float& lrow) {
    const int q = lane & 31, hi = lane >> 5;
    const int jmin = m0 >= 128 ? 0 : ((128 - m0) >> 5);
    bf16x8 qf[4];
    { const bf16* qrow = Qp + (size_t)(m0 + q) * 64 + hi * 8;
#pragma unroll
      for (int ks = 0; ks < 4; ++ks) qf[ks] = *(const GAS bf16x8*)(qrow + 16 * ks); }
    const bf16* krow = Kp + ((ptrdiff_t)(m0 - 128 + swap23(q))) * 64 + hi * 8;
    bf16x8 kf[5][4];
#pragma unroll
    for (int j = 0; j < 5; ++j) if (j >= jmin) {
#pragma unroll
        for (int ks = 0; ks < 4; ++ks) kf[j][ks] = *(const GAS bf16x8*)(krow + j * 32 * 64 + 16 * ks); }
    f32x16 s[5];
#pragma unroll
    for (int j = 0; j < 5; ++j) {
#pragma unroll
        for (int r = 0; r < 16; ++r) s[j][r] = 0.f;
        if (j >= jmin) {
#pragma unroll
            for (int ks = 0; ks < 4; ++ks) s[j] = __builtin_amdgcn_mfma_f32_32x32x16_bf16(kf[j][ks], qf[ks], s[j], 0, 0, 0); } }
    __builtin_amdgcn_sched_barrier(0);
    const bf16* vrow = Vp + (size_t)q * 2048 + (m0 - 128) + 8 * hi;
    bf16x8 vf[5][2][2];
#pragma unroll
    for (int j = 0; j < 5; ++j) if (j >= jmin) {
#pragma unroll
        for (int s2 = 0; s2 < 2; ++s2) { vf[j][s2][0] = *(const GAS bf16x8*)(vrow + 32 * j + 16 * s2); vf[j][s2][1] = *(const GAS bf16x8*)(vrow + 32 * 2048 + 32 * j + 16 * s2); } }
    const LAS float* tb = tab + (4 + q - 8 * hi);
    float mx = -3e38f;
#pragma unroll
    for (int j = 0; j < 5; ++j) if (j >= jmin) {
#pragma unroll
        for (int r = 0; r < 16; ++r) { const int cr = (r & 3) + 4 * ((r >> 2) & 1) + 16 * (r >> 3); s[j][r] += tb[155 - 32 * j - cr]; mx = fmaxf(mx, s[j][r]); } }
    mx = swapmax(mx);
    float ls = 0.f;
#pragma unroll
    for (int j = 0; j < 5; ++j) if (j >= jmin) {
#pragma unroll
        for (int r = 0; r < 16; ++r) { const float p = __builtin_amdgcn_exp2f(s[j][r] - mx); s[j][r] = p; ls += p; } }
    ls = swapsum(ls);
#pragma unroll
    for (int r = 0; r < 16; ++r) { o0[r] = 0.f; o1[r] = 0.f; }
#pragma unroll
    for (int j = 0; j < 5; ++j) if (j >= jmin) {
#pragma unroll
        for (int s2 = 0; s2 < 2; ++s2) {
            u32x4 pw; pw.x = cvtpk(s[j][8 * s2 + 0], s[j][8 * s2 + 1]); pw.y = cvtpk(s[j][8 * s2 + 2], s[j][8 * s2 + 3]); pw.z = cvtpk(s[j][8 * s2 + 4], s[j][8 * s2 + 5]); pw.w = cvtpk(s[j][8 * s2 + 6], s[j][8 * s2 + 7]);
            const bf16x8 pf = __builtin_bit_cast(bf16x8, pw);
            o0 = __builtin_amdgcn_mfma_f32_32x32x16_bf16(vf[j][s2][0], pf, o0, 0, 0, 0);
            o1 = __builtin_amdgcn_mfma_f32_32x32x16_bf16(vf[j][s2][1], pf, o1, 0, 0, 0); } }
    mrow = mx; lrow = ls;
}

__device__ __forceinline__ void attn_phase(Frame& F, CArgs args, int half) {
    int lane_ = lane_id(); asm volatile("" : "+v"(lane_));
    const int lane = lane_, wave = F.wave, q = lane & 31, hi = lane >> 5;
    LAS unsigned char* lds = F.lds;
    LAS float* tabs = (LAS float*)(lds + AT_TAB);
    LAS float* lses = (LAS float*)(lds + AT_LSE);
    for (int u = blockIdx.x; u < 256; u += F.G) {
        const int c = u & 3, hh = (u >> 2) & 15, bl = u >> 6;
        for (int i = (F.wave * 64 + lane_id()); i < 3 * 192; i += 512) { const int g = i / 192, idx = i % 192, dist = idx - 31;
            tabs[i] = (dist >= 0 && dist <= 128) ? P_small[SM_BIAS + (g * 16 + hh) * 192 + dist] : NEGV; }
        __syncthreads();
        for (int tk = wave; tk < 32; tk += 8) {
            const int g = tk < 16 ? 2 : 1, k = tk & 15;
            const int r_ = g == 2 ? k : (k >> 2), a = g == 2 ? 0 : (k & 3);
            const int sh = 2 * g, L = 2048 >> sh;
            const int m0 = g == 2 ? 32 * c : 128 * c + 32 * a;
            const size_t hb = (size_t)((bl * 3 + g) * 16 + hh);
            const bf16* Qp = P_Qh + (hb * 2048 + (size_t)r_ * L) * 64; const bf16* Kp = P_Kh + (hb * 2048 + (size_t)r_ * L) * 64; const bf16* Vp = P_VTh + hb * 64 * 2048 + (size_t)r_ * L;
            f32x16 o0, o1; float mr, lr;
            task(Qp, Kp, Vp, m0, tabs + g * 192, lane, o0, o1, mr, lr);
            const float inv = 1.f / lr;
            const int row = g == 2 ? 16 * q + r_ : 4 * (32 * a + q) + r_;
            LAS unsigned char* ob = lds + AT_OL + (g == 2 ? 65536 : 0);
#pragma unroll
            for (int d0 = 0; d0 < 2; ++d0)
#pragma unroll
                for (int r4 = 0; r4 < 4; ++r4) { const f32x16& o = d0 ? o1 : o0;
                    u32x2 w; w.x = cvtpk(o[4 * r4] * inv, o[4 * r4 + 1] * inv); w.y = cvtpk(o[4 * r4 + 2] * inv, o[4 * r4 + 3] * inv);
                    *(LAS u32x2*)(ob + olds_off(row, 8 * d0 + 2 * r4 + hi)) = w; }
            if (hi == 0) lses[(g == 2 ? 512 : 0) + row] = mr + log2f(lr);
        }
        __syncthreads();
        for (int j0 = wave; j0 < 16; j0 += 8) {
            const size_t hb = (size_t)((bl * 3 + 0) * 16 + hh);
            const bf16* Qp = P_Qh + hb * 2048 * 64; const bf16* Kp = P_Kh + hb * 2048 * 64; const bf16* Vp = P_VTh + hb * 64 * 2048;
            f32x16 o0, o1; float mr, lr;
            task(Qp, Kp, Vp, 512 * c + 32 * j0, tabs, lane, o0, o1, mr, lr);
            const int row = 32 * j0 + q;
            const float l0 = mr + log2f(lr), l1 = lses[row], l2 = lses[512 + row];
            const float mt = fmaxf(fmaxf(l0, l1), l2);
            float w0 = __builtin_amdgcn_exp2f(l0 - mt), w1 = __builtin_amdgcn_exp2f(l1 - mt), w2 = __builtin_amdgcn_exp2f(l2 - mt);
            const float wi = 1.f / (w0 + w1 + w2); w0 *= wi / lr; w1 *= wi; w2 *= wi;
            const size_t ml = (size_t)bl * 2048 + 512 * c + row;
            const bf16* szp = P_SZh + ml * 1024 + hh * 64; bf16* ogp = P_OG + ((size_t)half * HM + ml) * 1024 + hh * 64;
#pragma unroll
            for (int d0 = 0; d0 < 2; ++d0)
#pragma unroll
                for (int r4 = 0; r4 < 4; ++r4) { const f32x16& o = d0 ? o1 : o0; const int col8 = 8 * d0 + 2 * r4 + hi;
                    const u32x2 a1 = *(const LAS u32x2*)(lds + AT_OL + olds_off(row, col8)), a2 = *(const LAS u32x2*)(lds + AT_OL + 65536 + olds_off(row, col8));
                    const u32x2 zz = *(const GAS u32x2*)(szp + 4 * col8);
                    float v[4];
#pragma unroll
                    for (int e = 0; e < 4; ++e) {
                        const unsigned x1 = e < 2 ? a1.x : a1.y, x2 = e < 2 ? a2.x : a2.y, xz = e < 2 ? zz.x : zz.y;
                        const float f1 = __builtin_bit_cast(float, (e & 1) ? (x1 & 0xffff0000u) : (x1 << 16)), f2 = __builtin_bit_cast(float, (e & 1) ? (x2 & 0xffff0000u) : (x2 << 16));
                        const float fz = __builtin_bit_cast(float, (e & 1) ? (xz & 0xffff0000u) : (xz << 16));
                        v[e] = (w0 * o[4 * r4 + e] + w1 * f1 + w2 * f2) * fz; }
                    u32x2 w; w.x = cvtpk(v[0], v[1]); w.y = cvtpk(v[2], v[3]);
                    *(GAS u32x2*)(ogp + 4 * col8) = w; }
        }
        __syncthreads();
    }
}
}

namespace s5 {
constexpr int SU = 0, UROW = 528, SS = 67584;
__device__ __forceinline__ void scan_phase(Frame& F, CArgs args) {
    const int lane = lane_id(), wave = F.wave, q = lane & 31, hi = lane >> 5, tid = wave * 64 + lane;
    LAS unsigned char* lds = F.lds;
    LAS float* Sx = (LAS float*)(lds + SS);
    int ui = 0;
    for (int u = blockIdx.x; u < 512; u += F.G, ++ui) {
        const int g = u & 63, b = u >> 6;
        const bf16* Ug = P_UG + (size_t)(b * 64 + g) * 2048 * 16;
#pragma unroll
        for (int i = 0; i < 8; ++i) { const int idx = tid + 512 * i; const u32x4 v = *(const GAS u32x4*)(Ug + (size_t)idx * 8); *(LAS u32x4*)(lds + SU + (idx >> 5) * UROW + (idx & 31) * 16) = v; }
        __syncthreads();
        {
            const int nb = wave & 3;
            const bf16* w1p = WSB(WS_W1) + ((size_t)g * 128 + 32 * nb + q) * 256 + 8 * hi;
            bf16x8 bfr[16];
#pragma unroll
            for (int ks = 0; ks < 16; ++ks) bfr[ks] = *(const GAS bf16x8*)(w1p + 16 * ks);
#pragma unroll
            for (int cbi = 0; cbi < 2; ++cbi) { const int cb = 2 * (wave >> 2) + cbi; f32x16 acc = {};
                const LAS unsigned char* ap = lds + SU + (32 * cb + q) * UROW + 16 * hi;
#pragma unroll
                for (int ks = 0; ks < 16; ++ks) { const bf16x8 a = *(const LAS bf16x8*)(ap + 32 * ks); acc = __builtin_amdgcn_mfma_f32_32x32x16_bf16(a, bfr[ks], acc, 0, 0, 0); }
#pragma unroll
                for (int r = 0; r < 16; ++r) Sx[(32 * cb + (r & 3) + 8 * (r >> 2) + 4 * hi) * 128 + 32 * nb + q] = acc[r]; }
        }
        __syncthreads();
        const int nb3 = (ui & 1) ? 7 - wave : wave;
        bf16x8 wy[24];
        { const bf16* wyp = WSB(WS_WY) + ((size_t)g * 256 + 32 * nb3 + q) * 384 + 8 * hi;
#pragma unroll
          for (int ks = 0; ks < 16; ++ks) if (ks <= 2 * nb3 + 1) wy[ks] = *(const GAS bf16x8*)(wyp + 16 * ks);
#pragma unroll
          for (int ks = 16; ks < 24; ++ks) wy[ks] = *(const GAS bf16x8*)(wyp + 16 * ks); }
        if (wave == 0) {
            const int p = lane;
            const float lr = P_small[SM_LAMT + 2 * (g * 64 + p)], li = P_small[SM_LAMT + 2 * (g * 64 + p) + 1];
            float xr = 0.f, xi = 0.f;
            for (int c0 = 0; c0 < 128; c0 += 8) {
                float sr[8], si[8];
#pragma unroll
                for (int j = 0; j < 8; ++j) { sr[j] = Sx[(c0 + j) * 128 + p]; si[j] = Sx[(c0 + j) * 128 + 64 + p]; }
                asm volatile("" ::: "memory");
#pragma unroll
                for (int j = 0; j < 8; ++j) { const int c = c0 + j;
                    LAS unsigned char* row = lds + SS + c * 512;
                    *(LAS unsigned short*)(row + ((((p >> 3)) ^ (c & 15)) << 4) + (p & 7) * 2) = (unsigned short)f2bf(xr);
                    *(LAS unsigned short*)(row + (((8 + (p >> 3)) ^ (c & 15)) << 4) + (p & 7) * 2) = (unsigned short)f2bf(xi);
                    const float nr = lr * xr - li * xi + sr[j], ni = lr * xi + li * xr + si[j]; xr = nr; xi = ni; }
                asm volatile("" ::: "memory");
            }
        }
        __syncthreads();
        {
#pragma unroll 1
            for (int cb = 0; cb < 4; ++cb) { f32x16 acc = {};
                const int crow_ = 32 * cb + q;
                const LAS unsigned char* ap = lds + SU + crow_ * UROW + 16 * hi;
#pragma unroll
                for (int ks = 0; ks < 16; ++ks) if (ks <= 2 * nb3 + 1) { const bf16x8 a = *(const LAS bf16x8*)(ap + 32 * ks); acc = __builtin_amdgcn_mfma_f32_32x32x16_bf16(a, wy[ks], acc, 0, 0, 0); }
                const LAS unsigned char* xp = lds + SS + crow_ * 512;
#pragma unroll
                for (int k2 = 0; k2 < 8; ++k2) { const bf16x8 a = *(const LAS bf16x8*)(xp + (((2 * k2 + hi) ^ (crow_ & 15)) << 4)); acc = __builtin_amdgcn_mfma_f32_32x32x16_bf16(a, wy[16 + k2], acc, 0, 0, 0); }
                const int tau = 2 * nb3 + (q >> 4), co = q & 15;
#pragma unroll
                for (int r = 0; r < 16; ++r) { const int chunk = 32 * cb + (r & 3) + 8 * (r >> 2) + 4 * hi;
                    P_GB[((size_t)b * 2048 + 16 * chunk + tau) * 1024 + g * 16 + co] = (bf16)f2bf(gelu_tanh_f(acc[r])); } }
        }
        __syncthreads();
    }
}
}

__device__ __forceinline__ void naive_attn(Frame& F, CArgs args, int half) {
    const int gw = blockIdx.x * 8 + F.wave, NGW = F.G * 8, lane = lane_id();
    const float* bias = P_small + SM_BIAS;
    for (int it = gw; it < 4 * 2048 * 16; it += NGW) {
        const int hh = it & 15, t = (it >> 4) & 2047, bl = it >> 15;
        float og[3], lse[3];
#pragma unroll
        for (int g = 0; g < 3; ++g) {
            const int sh = 2 * g, L = 2048 >> sh, r_ = t & ((1 << sh) - 1), m_ = t >> sh;
            const size_t hb = (size_t)((bl * 3 + g) * 16 + hh);
            const size_t rowq = hb * 2048 + r_ * L + m_;
            const float qe = bf2f(P_Qh[rowq * 64 + lane]);
            float s0 = -INFINITY, s1 = -INFINITY, s2 = -INFINITY;
            const int jmax = m_ < 128 ? m_ : 128;
            const float* bt = bias + (g * 16 + hh) * 192;
            for (int j = 0; j <= jmax; ++j) {
                const float kv = bf2f(P_Kh[(rowq - j) * 64 + lane]);
                const float tot = wave_sum(qe * kv) + bt[j];
                if (j < 64) { if (lane == j) s0 = tot; } else if (j < 128) { if (lane == j - 64) s1 = tot; } else { if (lane == 0) s2 = tot; }
            }
            const float mx = wave_max(fmaxf(fmaxf(s0, s1), s2));
            const float p0 = exp2f(s0 - mx), p1 = exp2f(s1 - mx), p2 = exp2f(s2 - mx);
            const float sum = wave_sum(p0 + p1 + p2);
            float o = 0.f;
            const bf16* vp = P_VTh + (hb * 64 + lane) * 2048 + r_ * L + m_;
            for (int j = 0; j <= jmax; ++j) {
                const float pj = __shfl(j < 64 ? p0 : (j < 128 ? p1 : p2), j & 63);
                o += pj * bf2f(vp[-j]);
            }
            og[g] = o / sum; lse[g] = mx + log2f(sum);
        }
        const float mx = fmaxf(fmaxf(lse[0], lse[1]), lse[2]);
        const float w0 = exp2f(lse[0] - mx), w1 = exp2f(lse[1] - mx), w2 = exp2f(lse[2] - mx);
        const float o = (w0 * og[0] + w1 * og[1] + w2 * og[2]) / (w0 + w1 + w2);
        const size_t ml = (size_t)bl * 2048 + t;
        const float sz = bf2f(P_SZh[ml * 1024 + hh * 64 + lane]);
        P_OG[((size_t)half * HM + ml) * 1024 + hh * 64 + lane] = (bf16)f2bf(o * sz);
    }
}

__device__ __forceinline__ void naive_scan(Frame& F, CArgs args) {
    const int gw = blockIdx.x * 8 + F.wave, NGW = F.G * 8, lane = lane_id();
    for (int it = gw; it < 8 * 64; it += NGW) {
        const int g = it & 63, b = it >> 6;
        const int gp = g * 64 + lane;
        const float lr = P_small[SM_LAM + 2 * gp], li = P_small[SM_LAM + 2 * gp + 1];
        float xr = 0.f, xi = 0.f;
        const bf16* up = P_UG + (size_t)(b * 64 + g) * 2048 * 16;
        const float dsk = P_dskip[g * 16 + (lane & 15)];
        float bbr[16], bbi[16], ccr[16], cci[16];
#pragma unroll
        for (int c = 0; c < 16; ++c) { bbr[c] = P_small[SM_BBAR + (gp * 16 + c) * 2]; bbi[c] = P_small[SM_BBAR + (gp * 16 + c) * 2 + 1];
            ccr[c] = P_c_re[(g * 16 + c) * 64 + lane]; cci[c] = P_c_im[(g * 16 + c) * 64 + lane]; }
        for (int t = 0; t < 2048; ++t) {
            float bur = 0.f, bui = 0.f;
            float uown = 0.f;
#pragma unroll
            for (int c = 0; c < 16; ++c) {
                const float u = bf2f(up[t * 16 + c]);
                bur += bbr[c] * u; bui += bbi[c] * u;
                if ((lane & 15) == c) uown = u;
            }
            const float nr = lr * xr - li * xi + bur, ni = lr * xi + li * xr + bui;
            xr = nr; xi = ni;
            float yown = 0.f;
#pragma unroll
            for (int c = 0; c < 16; ++c) {
                const float v = ccr[c] * xr - cci[c] * xi;
                const float tot = wave_sum(v);
                if ((lane & 15) == c) yown = tot;
            }
            if (lane < 16) {
                const float y = yown + dsk * uown;
                P_GB[((size_t)b * 2048 + t) * 1024 + g * 16 + lane] = (bf16)f2bf(gelu_tanh_f(y));
            }
        }
    }
}

__device__ __forceinline__ void row_pass1(Frame& F, CArgs args) {
    const int gw = blockIdx.x * 8 + F.wave, NGW = F.G * 8, lane = lane_id();
    for (int m = gw; m < M; m += NGW) {
        const GAS f32x4* hr = (const GAS f32x4*)(P_H2 + (size_t)m * D) + lane; const GAS f32x4* xr = (const GAS f32x4*)(P_x + (size_t)m * D) + lane;
        const GAS f32x4* g1 = (const GAS f32x4*)P_attn_post + lane; const GAS f32x4* g2 = (const GAS f32x4*)P_ssm_pre + lane;
        f32x4 v[4]; float s = 0.f;
#pragma unroll
        for (int j = 0; j < 4; ++j) { v[j] = hr[64 * j]; s += (v[j].x * v[j].x + v[j].y * v[j].y) + (v[j].z * v[j].z + v[j].w * v[j].w); }
        const float rs = 1.f / sqrtf(wave_sum(s) * (1.f / D) + EPS);
        float s2 = 0.f;
#pragma unroll
        for (int j = 0; j < 4; ++j) { v[j] = xr[64 * j] + v[j] * rs * g1[64 * j]; s2 += (v[j].x * v[j].x + v[j].y * v[j].y) + (v[j].z * v[j].z + v[j].w * v[j].w); }
        const float rs2 = 1.f / sqrtf(wave_sum(s2) * (1.f / D) + EPS);
        GAS f32x4* o = (GAS f32x4*)(P_out + (size_t)m * D) + lane;
        GAS unsigned long long* o8 = (GAS unsigned long long*)(P_XN2 + (size_t)m * D) + lane;
#pragma unroll
        for (int j = 0; j < 4; ++j) { o[64 * j] = v[j]; const f32x4 g = g2[64 * j];
            o8[64 * j] = (unsigned long long)pk2(v[j].x * rs2 * g.x, v[j].y * rs2 * g.y) | ((unsigned long long)pk2(v[j].z * rs2 * g.z, v[j].w * rs2 * g.w) << 32); }
    }
}
__device__ __forceinline__ void row_pass2(Frame& F, CArgs args) {
    const int gw = blockIdx.x * 8 + F.wave, NGW = F.G * 8, lane = lane_id();
    for (int m = gw; m < M; m += NGW) {
        const GAS f32x4* hr = (const GAS f32x4*)(P_H3 + (size_t)m * D) + lane; GAS f32x4* o = (GAS f32x4*)(P_out + (size_t)m * D) + lane;
        const GAS f32x4* g1 = (const GAS f32x4*)P_ssm_post + lane;
        f32x4 v[4]; float s = 0.f;
#pragma unroll
        for (int j = 0; j < 4; ++j) { v[j] = hr[64 * j]; s += (v[j].x * v[j].x + v[j].y * v[j].y) + (v[j].z * v[j].z + v[j].w * v[j].w); }
        const float rs = 1.f / sqrtf(wave_sum(s) * (1.f / D) + EPS);
#pragma unroll
        for (int j = 0; j < 4; ++j) o[64 * j] = o[64 * j] + v[j] * rs * g1[64 * j];
    }
}

__global__ void __launch_bounds__(512, 2) mk_fwd(Args kargs_unused) {
    CArgs args = (CArgs)__builtin_amdgcn_kernarg_segment_ptr();
    extern __shared__ __attribute__((aligned(16))) unsigned char lds[];
    Frame F;
    F.lds = (LAS unsigned char*)lds;
    F.wave = __builtin_amdgcn_readfirstlane(threadIdx.x >> 6);
    F.G = gridDim.x;
    gu32* ctl = (gu32*)(args->ws + WS_CTL);
    volatile LAS unsigned* MISC = (volatile LAS unsigned*)(F.lds + MISC_OFF);
    for (int u = (F.wave * 64 + lane_id()); u < (LDS_BYTES - LDSCTL_OFF) / 4; u += 512) ((LAS unsigned*)(F.lds + LDSCTL_OFF))[u] = 0u;
    __syncthreads();
    XcdBarrier bar; bar.bar = (unsigned*)(ctl + CW_BAR); bar.x = 0; bar.st = nullptr;
    if (N_LAUNCHES == 1) bar = xcd_barrier_post((unsigned*)(ctl + CW_BAR), MISC + 8, F.wave);
    const int lo = args->ph_lo, hi = args->ph_hi; (void)lo; (void)hi;
#define OPQ() asm volatile("" : "+s"(args))
#if MK_N_LAUNCHES == 1
#define IN(k) true
#define SEAM(k) xcd_barrier(bar, F.wave)
#else
#define IN(k) (lo <= (k) && (k) < hi)
#define SEAM(k) do { if (IN(k) && IN((k) + 1)) xcd_barrier(bar, F.wave); } while (0)
#endif

    if (IN(0)) { OPQ(); p0_prologue(F, args); } SEAM(0);
    for (int half = 0; half < 2; ++half) {
        if (IN(1 + 2 * half)) { OPQ();
#if OPT_GEMM_IN
            pg8::ProbInProj P{P_XN + (size_t)half * HM * D, P_Wt_in, D}; pg8::StaticOrder S; S.init(HM, NIN, F.G, (int)blockIdx.x);
            pg8::EpiInProj E{P_Qh, P_Kh, P_VTh, P_SZh}; pg8::gemm_phase<pg8::EpiInProj, pg8::ProbInProj, true>(F.lds, F.wave, P, S, E);
#else
            EnInProj E{P_Qh, P_Kh, P_VTh, P_SZh}; naive_gemm(F, P_XN + (size_t)half * HM * D, P_Wt_in, HM, NIN, D, E);
#endif
        } SEAM(1 + 2 * half);
        if (IN(2 + 2 * half)) { OPQ();
#if OPT_ATTN
            att::attn_phase(F, args, half);
#else
            naive_attn(F, args, half);
#endif
        } SEAM(2 + 2 * half);
    }
    if (IN(5)) { OPQ();
#if OPT_GEMM_AO
        pg8::ProbPlain P{P_OG, P_Wt_ao, D}; pg8::StaticOrder S; S.init(M, D, F.G, (int)blockIdx.x);
        pg8::EpiF32 E{P_H2, D}; pg8::gemm_phase<pg8::EpiF32, pg8::ProbPlain, false>(F.lds, F.wave, P, S, E);
#else
        EnF32 E{P_H2}; naive_gemm(F, P_OG, P_Wt_ao, M, D, D, E);
#endif
    } SEAM(5);
    if (IN(6)) { OPQ(); row_pass1(F, args); } SEAM(6);
    if (IN(7)) { OPQ();
#if OPT_GEMM_SI
        pg8::ProbPlain P{P_XN2, P_Wt_si, D}; pg8::StaticOrder S; S.init(M, 2 * D, F.G, (int)blockIdx.x);
        pg8::EpiSsmIn E{P_UG, P_SZ2}; pg8::gemm_phase<pg8::EpiSsmIn, pg8::ProbPlain, true>(F.lds, F.wave, P, S, E);
#else
        EnSsmIn E{P_UG, P_SZ2}; naive_gemm(F, P_XN2, P_Wt_si, M, 2 * D, D, E);
#endif
    } SEAM(7);
    if (IN(8)) { OPQ();
#if OPT_SCAN
        s5::scan_phase(F, args);
#else
        naive_scan(F, args);
#endif
    } SEAM(8);
    if (IN(9)) { OPQ();
#if OPT_GEMM_GLU
        pg8::ProbPlain P{P_GB, P_Wt_glu, D}; pg8::StaticOrder S; S.init(M, D, F.G, (int)blockIdx.x);
        pg8::EpiGlu E{P_GB, P_SZ2, P_b_glu, P_Y2}; pg8::gemm_phase<pg8::EpiGlu, pg8::ProbPlain, false>(F.lds, F.wave, P, S, E);
#else
        EnGlu E{P_GB, P_SZ2, P_b_glu, P_Y2}; naive_gemm(F, P_GB, P_Wt_glu, M, D, D, E);
#endif
    } SEAM(9);
    if (IN(10)) { OPQ();
#if OPT_GEMM_SO
        pg8::ProbPlain P{P_Y2, P_Wt_so, D}; pg8::StaticOrder S; S.init(M, D, F.G, (int)blockIdx.x);
        pg8::EpiF32 E{P_H3, D}; pg8::gemm_phase<pg8::EpiF32, pg8::ProbPlain, false>(F.lds, F.wave, P, S, E);
#else
        EnF32 E{P_H3}; naive_gemm(F, P_Y2, P_Wt_so, M, D, D, E);
#endif
    } SEAM(10);
    if (IN(11)) { OPQ(); row_pass2(F, args); }
#undef IN
#undef SEAM
}

extern "C" void kernel_launch(void* const* d_in, const int* in_sizes, int n_in, void* d_out, int out_size, void* d_ws, size_t ws_size, hipStream_t stream) {
    static int grid = 0;
    if (grid == 0) {
        if (n_in != 20 || out_size != M * D || ws_size < WS_END) { fprintf(stderr, "kernel_launch: unexpected shapes n_in %d out %d ws %zu\n", n_in, out_size, ws_size); grid = -1; return; }
        int dev = 0, cus = 0, per_cu = 0;
        if (hipGetDevice(&dev) != hipSuccess || hipDeviceGetAttribute(&cus, hipDeviceAttributeMultiprocessorCount, dev) != hipSuccess) { grid = -1; return; }
        if (hipFuncSetAttribute((const void*)mk_fwd, hipFuncAttributeMaxDynamicSharedMemorySize, LDS_BYTES) != hipSuccess) { fprintf(stderr, "kernel_launch: hipFuncSetAttribute failed\n"); grid = -1; return; }
        if (hipOccupancyMaxActiveBlocksPerMultiprocessor(&per_cu, (const void*)mk_fwd, 512, LDS_BYTES) != hipSuccess || per_cu < 1) { fprintf(stderr, "kernel_launch: occupancy query says %d\n", per_cu); per_cu = 1; }
        (void)hipGetLastError();
        grid = cus;
    }
    if (grid < 0) return;
    (void)hipMemsetAsync((char*)d_ws + WS_CTL, 0, CTL_ZERO_BYTES, stream);
    Args a{};
    for (int i = 0; i < 20; ++i) a.in[i] = (const float*)d_in[i];
    a.out = (float*)d_out; a.ws = (unsigned char*)d_ws;
    for (int li = 0; li < N_LAUNCHES; ++li) {
        a.ph_lo = (N_LAUNCHES == 1) ? 0 : li; a.ph_hi = (N_LAUNCHES == 1) ? NPH : li + 1; a.li = li;
        hipLaunchKernelGGL(mk_fwd, dim3(grid), dim3(512), LDS_BYTES, stream, a);
    }
}
```

```cpp
#include <hip/hip_runtime.h>
#include <cstdio>
#include <cstdint>

#ifndef MK_N_LAUNCHES
#define MK_N_LAUNCHES 1
#endif
#define OPT_GEMM_IN 1
#define OPT_GEMM_AO 1
#define OPT_GEMM_SI 1
#define OPT_GEMM_GLU 1
#define OPT_GEMM_SO 1
#define OPT_ATTN 1
#define OPT_SCAN 1
#ifndef PROBE_DUP
#define PROBE_DUP 0
#endif
#define REP(k) for (int rep_ = 0; rep_ < 1 + ((PROBE_DUP >> (k)) & 1); ++rep_)

#define GAS __attribute__((address_space(1)))
#define LAS __attribute__((address_space(3)))
typedef unsigned short bf16;
typedef short bf16x8 __attribute__((ext_vector_type(8)));
typedef float f32x4 __attribute__((ext_vector_type(4)));
typedef float f32x16 __attribute__((ext_vector_type(16)));
typedef unsigned u32x4 __attribute__((ext_vector_type(4)));
typedef unsigned u32x2 __attribute__((ext_vector_type(2)));
typedef GAS unsigned gu32;

constexpr int BATCH = 8, SEQ = 2048, D = 1024, M = BATCH * SEQ;
constexpr int NIN = 10240;
constexpr int HM = M / 2;
constexpr int NPH = 12;
constexpr int N_LAUNCHES = MK_N_LAUNCHES;
constexpr float EPS = 1e-6f;
constexpr float LOG2E = 1.4426950408889634f;
constexpr float C2 = 0.125f * LOG2E;

constexpr size_t MiB = 1u << 20;
constexpr size_t WS_CTL = 0, CTL_ZERO_BYTES = 1 * MiB;
constexpr size_t WS_WT_IN = 2 * MiB, WS_WT_AO = 22 * MiB, WS_WT_SI = 24 * MiB, WS_WT_GLU = 28 * MiB, WS_WT_SO = 30 * MiB;
constexpr size_t WS_W1 = 32 * MiB, WS_WY = 36 * MiB;
constexpr size_t WS_SMALL = 48 * MiB;
constexpr size_t WS_OG = 49 * MiB;
constexpr size_t WS_Q = 81 * MiB, WS_K = 129 * MiB, WS_VT = 177 * MiB, WS_SZ = 225 * MiB;
constexpr size_t WS_H2 = 81 * MiB;
constexpr size_t WS_XN2 = 145 * MiB, WS_UG = 177 * MiB, WS_SZ2 = 209 * MiB;
constexpr size_t WS_GB = 81 * MiB, WS_Y2 = 113 * MiB, WS_H3 = 145 * MiB;
constexpr size_t WS_END = 256 * MiB;
constexpr int SM_LAM = 0;
constexpr int SM_LAMT = SM_LAM + 64 * 64 * 2;
constexpr int SM_BBAR = SM_LAMT + 64 * 64 * 2;
constexpr int SM_BIAS = SM_BBAR + 64 * 64 * 16 * 2;
constexpr int SM_END = SM_BIAS + 3 * 16 * 192;
static_assert((size_t)SM_END * 4 <= 1 * MiB, "small tables");
constexpr int CW_BAR = 4096;

constexpr int RING_BYTES = 131072;
constexpr int LDSCTL_OFF = 139264, MISC_OFF = LDSCTL_OFF + 320;
constexpr int LDS_BYTES = 147456;

#define RLX_AGENT __ATOMIC_RELAXED, __HIP_MEMORY_SCOPE_AGENT
__device__ __forceinline__ int lane_id() { int l = (int)__builtin_amdgcn_mbcnt_hi(~0u, __builtin_amdgcn_mbcnt_lo(~0u, 0u)); asm volatile("" : "+v"(l)); return l; }
__device__ __forceinline__ unsigned f2bf(float f) { unsigned u = __builtin_bit_cast(unsigned, f); return (u + 0x7fffu + ((u >> 16) & 1u)) >> 16; }
__device__ __forceinline__ unsigned pk2(float lo, float hi) { return f2bf(lo) | (f2bf(hi) << 16); }
__device__ __forceinline__ float bf2f(bf16 b) { return __builtin_bit_cast(float, ((unsigned)b) << 16); }
__device__ __forceinline__ float silu_f(float z) { return z / (1.f + __expf(-z)); }
__device__ __forceinline__ float sigmoid_f(float z) { return 1.f / (1.f + __expf(-z)); }
__device__ __forceinline__ float gelu_tanh_f(float x) { const float u = 0.7978845608028654f * (x + 0.044715f * x * x * x); const float t = 1.f - 2.f / (__expf(2.f * u) + 1.f); return 0.5f * x * (1.f + t); }
__device__ __forceinline__ float wave_sum(float v) {
#pragma unroll
    for (int o = 1; o < 64; o <<= 1) v += __shfl_xor(v, o);
    return v;
}
__device__ __forceinline__ float wave_max(float v) {
#pragma unroll
    for (int o = 1; o < 64; o <<= 1) v = fmaxf(v, __shfl_xor(v, o));
    return v;
}

#define XB_TMO      128
#define XB_XCNT(j)  (256  + 64 * (j))
#define XB_XSUB(j)  (1280 + 64 * (j))
#define XB_XGEN(j)  (2304 + 64 * (j))
#define XB_TOP      3328
#define XB_TOPGEN   3392
#define XCD_BAR_WORDS 3456
#define XB_SPIN_CAP (1u << 22)
__device__ __forceinline__ unsigned xb_ld(unsigned* p)              { return __hip_atomic_load(p, __ATOMIC_RELAXED, __HIP_MEMORY_SCOPE_AGENT); }
__device__ __forceinline__ unsigned xb_add(unsigned* p, unsigned v) { return __hip_atomic_fetch_add(p, v, __ATOMIC_RELAXED, __HIP_MEMORY_SCOPE_AGENT); }
__device__ __forceinline__ unsigned xb_xcc_id() { return (unsigned)__builtin_amdgcn_s_getreg((3 << 11) | 20) & 0xFu; }
#define XB_SPIN(cond, bar) do { unsigned _sp = 0; while (cond) { __builtin_amdgcn_s_sleep(1); \
    if ((++_sp & 255u) == 0u) { if (xb_ld(&(bar)[XB_TMO])) break; if (_sp > XB_SPIN_CAP) { atomicAdd(&(bar)[XB_TMO], 1u); break; } } } } while (0)
struct XcdBarrier { unsigned* bar; unsigned x; volatile LAS unsigned* st; };
__device__ __forceinline__ XcdBarrier xcd_barrier_post(unsigned* bar, volatile LAS unsigned* st, int wave) {
    XcdBarrier b; b.bar = bar; b.x = xb_xcc_id(); b.st = st;
    if (wave == 0 && lane_id() == 0) (void)xb_add(&bar[XB_XCNT(b.x)], 1u);
    return b;
}
__device__ __forceinline__ void xcd_barrier_complete(unsigned* bar, unsigned x, unsigned& nloc, unsigned& nx) {
    const unsigned G = gridDim.x * gridDim.y * gridDim.z;
    unsigned sum, cnt, mine, sp = 0u;
    for (;;) {
        sum = 0u; cnt = 0u; mine = 0u;
#pragma unroll
        for (unsigned j = 0; j < 16; ++j) { const unsigned c = xb_ld(&bar[XB_XCNT(j)]); sum += c; cnt += (c > 0u) ? 1u : 0u; mine = (j == x) ? c : mine; }
        if (sum == G) break;
        __builtin_amdgcn_s_sleep(1);
        if ((++sp & 255u) == 0u) { if (xb_ld(&bar[XB_TMO])) break; if (sp > XB_SPIN_CAP) { atomicAdd(&bar[XB_TMO], 1u); break; } }
    }
    nloc = mine > 0u ? mine : 1u; nx = cnt > 0u ? cnt : 1u;
}
__device__ __forceinline__ void xcd_barrier(const XcdBarrier& b, int wave) {
    asm volatile("s_waitcnt vmcnt(0)" ::: "memory");
    __syncthreads();
    if (wave == 0 && lane_id() == 0) {
        unsigned* bar = b.bar;
        __builtin_amdgcn_s_waitcnt(0);
        unsigned nloc = b.st[0], nx = b.st[1];
        if (nloc == 0u) { xcd_barrier_complete(bar, b.x, nloc, nx); b.st[0] = nloc; b.st[1] = nx; }
        const unsigned old = xb_add(&bar[XB_XSUB(b.x)], 1u);
        const unsigned gen = old / nloc;
        if (old + 1u == (gen + 1u) * nloc) {
            __builtin_amdgcn_fence(__ATOMIC_RELEASE, "agent");
            asm volatile("s_waitcnt vmcnt(0)" ::: "memory");
            const unsigned og = xb_add(&bar[XB_TOP], 1u);
            const unsigned tg = og / nx;
            if (og + 1u == (tg + 1u) * nx) xb_add(&bar[XB_TOPGEN], 1u);
            else XB_SPIN(xb_ld(&bar[XB_TOPGEN]) == tg, bar);
            __builtin_amdgcn_fence(__ATOMIC_ACQUIRE, "agent");
            xb_add(&bar[XB_XGEN(b.x)], 1u);
            asm volatile("s_waitcnt vmcnt(0)" ::: "memory");
        } else {
            XB_SPIN(xb_ld(&bar[XB_XGEN(b.x)]) == gen, bar);
            __builtin_amdgcn_fence(__ATOMIC_ACQUIRE, "agent");
            asm volatile("s_waitcnt vmcnt(0)" ::: "memory");
        }
    }
    __syncthreads();
}

struct Args { const float* in[20]; float* out; unsigned char* ws; int ph_lo, ph_hi, li, pad; };
struct Frame {
    LAS unsigned char* lds;
    int wave, G;
};
typedef const __attribute__((address_space(4))) Args* CArgs;
#define IN_(i) (args->in[i])
#define P_x IN_(0)
#define P_rel_bias IN_(1)
#define P_attn_pre IN_(2)
#define P_attn_win IN_(3)
#define P_attn_wout IN_(4)
#define P_attn_post IN_(5)
#define P_ssm_pre IN_(6)
#define P_ssm_win IN_(7)
#define P_a_re IN_(8)
#define P_a_im IN_(9)
#define P_log_dt IN_(10)
#define P_b_re IN_(11)
#define P_b_im IN_(12)
#define P_c_re IN_(13)
#define P_c_im IN_(14)
#define P_dskip IN_(15)
#define P_w_glu IN_(16)
#define P_b_glu IN_(17)
#define P_ssm_wout IN_(18)
#define P_ssm_post IN_(19)
#define WSB(off) ((bf16*)(args->ws + (off)))
#define WSF(off) ((float*)(args->ws + (off)))
#define P_Wt_in WSB(WS_WT_IN)
#define P_Wt_ao WSB(WS_WT_AO)
#define P_Wt_si WSB(WS_WT_SI)
#define P_Wt_glu WSB(WS_WT_GLU)
#define P_Wt_so WSB(WS_WT_SO)
#define P_XN ((bf16*)args->out)
#define P_OG WSB(WS_OG)
#define P_Qh WSB(WS_Q)
#define P_Kh WSB(WS_K)
#define P_VTh WSB(WS_VT)
#define P_SZh WSB(WS_SZ)
#define P_XN2 WSB(WS_XN2)
#define P_UG WSB(WS_UG)
#define P_SZ2 WSB(WS_SZ2)
#define P_GB WSB(WS_GB)
#define P_Y2 WSB(WS_Y2)
#define P_H2 WSF(WS_H2)
#define P_H3 WSF(WS_H3)
#define P_small WSF(WS_SMALL)
#define P_out (args->out)


__device__ __forceinline__ void p0_transpose_item(const float* W, int K, int N, bf16* WT, LAS float* scr, int item, int lane) {
    const int nblk = N / 32, kb = item / nblk, nb = item % nblk, k0 = 64 * kb, n0 = 32 * nb;
#pragma unroll 8
    for (int i = 0; i < 32; ++i) { const int kk = 2 * i + (lane >> 5); scr[kk * 33 + (lane & 31)] = W[(size_t)(k0 + kk) * N + n0 + (lane & 31)]; }
    asm volatile("s_waitcnt lgkmcnt(0)" ::: "memory");
    const int c = lane & 7;
#pragma unroll
    for (int j = 0; j < 4; ++j) { const int n = (lane >> 3) + 8 * j; const LAS float* s = scr + (8 * c) * 33 + n;
        u32x4 o; o.x = pk2(s[0 * 33], s[1 * 33]); o.y = pk2(s[2 * 33], s[3 * 33]); o.z = pk2(s[4 * 33], s[5 * 33]); o.w = pk2(s[6 * 33], s[7 * 33]);
        *(GAS u32x4*)(WT + (size_t)(n0 + n) * K + k0 + 8 * c) = o; }
    asm volatile("s_waitcnt lgkmcnt(0)" ::: "memory");
}
__device__ __forceinline__ void rms_row_to_bf16(const float* xrow, const float* gain, bf16* orow, int lane) {
    const GAS f32x4* xr = (const GAS f32x4*)xrow + lane; const GAS f32x4* gr = (const GAS f32x4*)gain + lane;
    f32x4 v[4]; float s = 0.f;
#pragma unroll
    for (int j = 0; j < 4; ++j) { v[j] = xr[64 * j]; s += (v[j].x * v[j].x + v[j].y * v[j].y) + (v[j].z * v[j].z + v[j].w * v[j].w); }
    const float rs = 1.f / sqrtf(wave_sum(s) * (1.f / D) + EPS);
    GAS unsigned long long* o8 = (GAS unsigned long long*)orow + lane;
#pragma unroll
    for (int j = 0; j < 4; ++j) { const f32x4 g = gr[64 * j]; o8[64 * j] = (unsigned long long)pk2(v[j].x * rs * g.x, v[j].y * rs * g.y) | ((unsigned long long)pk2(v[j].z * rs * g.z, v[j].w * rs * g.w) << 32); }
}
__device__ __forceinline__ int t5_bucket(int dist) {
    const int n = dist < 1 ? 1 : dist;
    int large = 16 + (int)(logf((float)n / 16.f) / 4.852030263919617f * 16.f);
    large = large < 31 ? large : 31;
    return dist < 16 ? dist : large;
}
__device__ __forceinline__ void p0_prologue(Frame& F, CArgs args) {
    LAS float* scr = (LAS float*)(F.lds + F.wave * 16384);
    const int gw = blockIdx.x * 8 + F.wave, NGW = F.G * 8;
    constexpr int I_IN = (D / 64) * (NIN / 32), I_AO = (D / 64) * (D / 32), I_SI = (D / 64) * (2 * D / 32);
    constexpr int NITEMS = I_IN + I_AO + I_SI + I_AO + I_AO;
    for (int it = gw; it < NITEMS; it += NGW) {
        int r = it;
        if (r < I_IN) { p0_transpose_item(P_attn_win, D, NIN, P_Wt_in, scr, r, lane_id()); continue; } r -= I_IN;
        if (r < I_AO) { p0_transpose_item(P_attn_wout, D, D, P_Wt_ao, scr, r, lane_id()); continue; } r -= I_AO;
        if (r < I_SI) { p0_transpose_item(P_ssm_win, D, 2 * D, P_Wt_si, scr, r, lane_id()); continue; } r -= I_SI;
        if (r < I_AO) { p0_transpose_item(P_w_glu, D, D, P_Wt_glu, scr, r, lane_id()); continue; } r -= I_AO;
        p0_transpose_item(P_ssm_wout, D, D, P_Wt_so, scr, r, lane_id());
    }
    for (int m = gw; m < M; m += NGW) rms_row_to_bf16(P_x + (size_t)m * D, P_attn_pre, P_XN + (size_t)m * D, lane_id());
    const int gt = blockIdx.x * 512 + (F.wave * 64 + lane_id()), NGT = F.G * 512;
    for (int i = gt; i < 64 * 64; i += NGT) {
        const int g = i >> 6;
        const float are = P_a_re[i], aim = P_a_im[i], dt = __expf(P_log_dt[g]);
        const float xr = are * dt, yi = aim * dt;
        float sn, cs; sincosf(yi, &sn, &cs);
        const float ex = expf(xr);
        P_small[SM_LAM + 2 * i] = ex * cs; P_small[SM_LAM + 2 * i + 1] = ex * sn;
        float sn16, cs16; sincosf(16.f * yi, &sn16, &cs16); const float ex16 = expf(16.f * xr);
        P_small[SM_LAMT + 2 * i] = ex16 * cs16; P_small[SM_LAMT + 2 * i + 1] = ex16 * sn16;
        const float sh = sinf(0.5f * yi);
        const float nr = expm1f(xr) * cs - 2.f * sh * sh, ni = ex * sn;
        const float den = are * are + aim * aim;
        const float fr = (nr * are + ni * aim) / den, fi = (ni * are - nr * aim) / den;
        for (int c = 0; c < 16; ++c) {
            const float br = P_b_re[i * 16 + c], bi = P_b_im[i * 16 + c];
            P_small[SM_BBAR + (i * 16 + c) * 2] = fr * br - fi * bi;
            P_small[SM_BBAR + (i * 16 + c) * 2 + 1] = fr * bi + fi * br;
        }
    }
    for (int i = gt; i < 3 * 16 * 192; i += NGT) {
        const int dist = i % 192, hh = (i / 192) & 15, g = i / (192 * 16);
        float v = -1e30f;
        if (dist <= 128) v = P_rel_bias[t5_bucket(dist << (2 * g)) * 16 + hh] * LOG2E;
        P_small[SM_BIAS + i] = v;
    }
    {
        const int tid = F.wave * 64 + lane_id();
        LAS float* lam = (LAS float*)F.lds;
        LAS float* bb = lam + 17 * 64 * 2;
        LAS float* cc = bb + 64 * 16 * 2;
        LAS float* kt = cc + 16 * 64 * 2;
        LAS float* ff = kt + 4096;
        for (int g = blockIdx.x; g < 64; g += F.G) {
            __syncthreads();
            const float dt = __expf(P_log_dt[g]);
            for (int i = tid; i < 17 * 64; i += 512) { const int l = i >> 6, p = i & 63; const float are = P_a_re[g * 64 + p], aim = P_a_im[g * 64 + p];
                float sn, cs; sincosf((float)l * (aim * dt), &sn, &cs); const float ex = expf((float)l * (are * dt)); lam[2 * i] = ex * cs; lam[2 * i + 1] = ex * sn; }
            if (tid < 64) { const float are = P_a_re[g * 64 + tid], aim = P_a_im[g * 64 + tid]; const float xr = are * dt, yi = aim * dt; float sn, cs; sincosf(yi, &sn, &cs);
                const float ex = expf(xr), sh = sinf(0.5f * yi), nr = expm1f(xr) * cs - 2.f * sh * sh, ni = ex * sn, den = are * are + aim * aim;
                ff[2 * tid] = (nr * are + ni * aim) / den; ff[2 * tid + 1] = (ni * are - nr * aim) / den; }
            for (int i = tid; i < 16 * 64; i += 512) { const int c = i >> 6, p = i & 63; cc[2 * i] = P_c_re[(g * 16 + c) * 64 + p]; cc[2 * i + 1] = P_c_im[(g * 16 + c) * 64 + p]; }
            __syncthreads();
            for (int i = tid; i < 64 * 16; i += 512) { const int p = i >> 4; const float br = P_b_re[g * 1024 + i], bi = P_b_im[g * 1024 + i], fr = ff[2 * p], fi = ff[2 * p + 1];
                bb[2 * i] = fr * br - fi * bi; bb[2 * i + 1] = fr * bi + fi * br; }
            __syncthreads();
            for (int i = tid; i < 4096; i += 512) { const int l = i >> 8, co = (i >> 4) & 15, ci = i & 15; float acc = 0.f;
                for (int p = 0; p < 64; ++p) { const float cr = cc[2 * (co * 64 + p)], cim = cc[2 * (co * 64 + p) + 1], lr = lam[2 * (l * 64 + p)], li = lam[2 * (l * 64 + p) + 1], br = bb[2 * (p * 16 + ci)], bi = bb[2 * (p * 16 + ci) + 1];
                    acc += cr * (lr * br - li * bi) - cim * (lr * bi + li * br); }
                if (l == 0 && co == ci) acc += P_dskip[g * 16 + co];
                kt[i] = acc; }
            __syncthreads();
            bf16* W1 = WSB(WS_W1) + (size_t)g * 128 * 256; bf16* WY = WSB(WS_WY) + (size_t)g * 256 * 384;
            for (int rr = tid; rr < 128 * 32; rr += 512) { const int n = rr >> 5, k0 = (rr & 31) * 8, s_ = k0 >> 4, c0 = k0 & 15, p = n & 63, im = n >> 6;
                const float lr = lam[2 * ((15 - s_) * 64 + p)], li = lam[2 * ((15 - s_) * 64 + p) + 1]; float v[8];
#pragma unroll
                for (int e = 0; e < 8; ++e) { const float br = bb[2 * (p * 16 + c0 + e)], bi = bb[2 * (p * 16 + c0 + e) + 1]; v[e] = im ? (lr * bi + li * br) : (lr * br - li * bi); }
                u32x4 o; o.x = pk2(v[0], v[1]); o.y = pk2(v[2], v[3]); o.z = pk2(v[4], v[5]); o.w = pk2(v[6], v[7]); *(GAS u32x4*)(W1 + (size_t)n * 256 + k0) = o; }
            for (int rr = tid; rr < 256 * 48; rr += 512) { const int n = rr / 48, k0 = (rr % 48) * 8, tau = n >> 4, co = n & 15; float v[8];
                if (k0 < 256) { const int s_ = k0 >> 4, ci0 = k0 & 15;
#pragma unroll
                    for (int e = 0; e < 8; ++e) v[e] = (tau >= s_) ? kt[((tau - s_) * 16 + co) * 16 + ci0 + e] : 0.f;
                } else {
#pragma unroll
                    for (int e = 0; e < 8; ++e) { const int kk = k0 - 256 + e, p = kk & 63, im = kk >> 6;
                        const float cr = cc[2 * (co * 64 + p)], cim = cc[2 * (co * 64 + p) + 1], lr = lam[2 * ((tau + 1) * 64 + p)], li = lam[2 * ((tau + 1) * 64 + p) + 1];
                        v[e] = im ? -(cr * li + cim * lr) : (cr * lr - cim * li); } }
                u32x4 o; o.x = pk2(v[0], v[1]); o.y = pk2(v[2], v[3]); o.z = pk2(v[4], v[5]); o.w = pk2(v[6], v[7]); *(GAS u32x4*)(WY + (size_t)n * 384 + k0) = o; }
        }
    }
}

__device__ __forceinline__ int sw23(int i) { return (i & ~12) | ((i & 4) << 1) | ((i & 8) >> 1); }
__device__ __forceinline__ int qk_off(int pos, int e, int isK) { const int slot = isK ? sw23(pos & 31) : (pos & 31); return (((((pos >> 5) * 4 + (e >> 4)) * 2 + ((e >> 3) & 1)) * 32 + slot) << 3) + (e & 7); }
__device__ __forceinline__ int vt_off(int pos, int e) { return ((((pos >> 3) << 6) + e) << 3) + (pos & 7); }

template <class Epi> __device__ __forceinline__ void naive_gemm(Frame& F, const bf16* A, const bf16* Bt, int Mrows, int N, int K, const Epi& epi) {
    const int ntn = N / 32, nt = (Mrows / 32) * ntn;
    const int gw = blockIdx.x * 8 + F.wave, NGW = F.G * 8;
    const int r32 = lane_id() & 31, hi = lane_id() >> 5;
    for (int tile = gw; tile < nt; tile += NGW) {
        const int tm = tile / ntn, tn = tile % ntn;
        f32x16 acc = {};
        const bf16* ap = A + (size_t)(tm * 32 + r32) * K + hi * 8;
        const bf16* bp = Bt + (size_t)(tn * 32 + r32) * K + hi * 8;
#pragma unroll 4
        for (int k = 0; k < K; k += 16) {
            const bf16x8 a = *(const GAS bf16x8*)(ap + k); const bf16x8 b = *(const GAS bf16x8*)(bp + k);
            acc = __builtin_amdgcn_mfma_f32_32x32x16_bf16(a, b, acc, 0, 0, 0);
        }
#pragma unroll
        for (int r = 0; r < 16; ++r) epi(tm * 32 + (r & 3) + 8 * (r >> 2) + 4 * hi, tn * 32 + r32, acc[r]);
    }
}
struct EnInProj {
    bf16 *Qh, *Kh, *VTh, *SZh;
    __device__ __forceinline__ void operator()(int m, int n, float v) const {
        const int bl = m >> 11, t = m & 2047;
        if (n < 9216) {
            const int tq = n / 3072, rem = n % 3072, g = rem >> 10, hh = (rem >> 6) & 15, e = rem & 63, sh = 2 * g;
            const int row = (t & ((1 << sh) - 1)) * (2048 >> sh) + (t >> sh);
            const size_t hb = (size_t)((bl * 3 + g) * 16 + hh);
            if (tq == 0) Qh[hb * 131072 + qk_off(row, e, 0)] = (bf16)f2bf(v * C2);
            else if (tq == 1) Kh[hb * 131072 + qk_off(row, e, 1)] = (bf16)f2bf(v);
            else VTh[hb * 131072 + vt_off(row, e)] = (bf16)f2bf(v);
        } else SZh[(size_t)m * 1024 + (n - 9216)] = (bf16)f2bf(silu_f(v));
    }
};
struct EnF32 { float* out; __device__ __forceinline__ void operator()(int m, int n, float v) const { out[(size_t)m * 1024 + n] = v; } };
struct EnSsmIn {
    bf16 *UG, *SZ2;
    __device__ __forceinline__ void operator()(int m, int n, float v) const {
        if (n < 1024) { const int g = n >> 4, c = n & 15, b = m >> 11, t = m & 2047; UG[((size_t)(b * 64 + g) * 2048 + t) * 16 + c] = (bf16)f2bf(v); }
        else SZ2[(size_t)m * 1024 + (n - 1024)] = (bf16)f2bf(silu_f(v));
    }
};
struct EnGlu {
    const bf16 *GB, *SZ2; const float* bglu; bf16* Y2;
    __device__ __forceinline__ void operator()(int m, int n, float v) const {
        const size_t o = (size_t)m * 1024 + n; const float gv = bf2f(GB[o]);
        Y2[o] = (bf16)f2bf(gv * sigmoid_f(v + bglu[n]) * bf2f(SZ2[o]));
    }
};

namespace pg8 {
constexpr int BM = 256, BK = 64, HALF = 128, HTB = HALF * BK * 2, STAGE_BYTES = 8 * HTB, NXCD = 8, WGM = 8;
__host__ __device__ __forceinline__ int lds_byte(int r, int c) { const int st = (r >> 4) * 2 + (c >> 5), rr = r & 15, cc = c & 31, ob = rr * 64 + cc * 2; return st * 1024 + (ob ^ (((ob >> 9) & 1) << 5)); }
__host__ __device__ __forceinline__ void stage_rc(int b, int& R, int& C) { const int st = b / 1024, sb = b % 1024, swz = sb ^ (((sb >> 9) & 1) << 5); R = (st >> 1) * 16 + swz / 64; C = (st & 1) * 32 + (swz % 64) / 2; }
__host__ __device__ __forceinline__ int perm32(int rho) { const int n = rho >> 4, i = rho & 15; return 8 * (i >> 2) + 4 * n + (i & 3); }
struct Unit { int pm, pn; };
struct StaticOrder {
    int nM, nN, nwg, G, c;
    __host__ __device__ void init(int M_, int N_, int G_, int c_) { nM = M_ / BM; nN = N_ / BM; nwg = nM * nN; G = G_; c = c_; }
    __host__ __device__ bool next(int i, Unit& u) const {
        const long L = (long)i * G + c; if (L >= nwg) return false;
        int wgid = (int)L; { const int q = nwg / NXCD, r = nwg % NXCD, xcd = wgid % NXCD, off = wgid / NXCD; wgid = (xcd < r ? xcd * (q + 1) : r * (q + 1) + (xcd - r) * q) + off; }
        const int nig = WGM * nN, gid = wgid / nig, fm = gid * WGM, gsz = (nM - fm) < WGM ? (nM - fm) : WGM;
        u.pm = fm + ((wgid % nig) % gsz); u.pn = (wgid % nig) / gsz; return true;
    }
};
__device__ __forceinline__ unsigned cvt_pk_bf16(float lo, float hi) { unsigned r; asm volatile("v_cvt_pk_bf16_f32 %0, %1, %2" : "=v"(r) : "v"(lo), "v"(hi)); return r; }
__device__ __forceinline__ u32x4 pack8(const f32x4& v0, const f32x4& v1) { u32x4 w; w.x = cvt_pk_bf16(v0[0], v0[1]); w.y = cvt_pk_bf16(v0[2], v0[3]); w.z = cvt_pk_bf16(v1[0], v1[1]); w.w = cvt_pk_bf16(v1[2], v1[3]); return w; }

struct ProbPlain {
    const bf16* A; const bf16* Bt; int K;
    static constexpr int NKIND = 1;
    __device__ __forceinline__ void operands(const Unit& u, const char*& cA, const char*& cB, int& kind) const {
        cA = (const char*)A + (size_t)u.pm * 256 * K * 2; cB = (const char*)Bt + (size_t)u.pn * 256 * K * 2; kind = 0; }
    __device__ __forceinline__ int brow(int kind, int cl) const { return cl; }
};
struct ProbInProj {
    const bf16* A; const bf16* Bt; int K;
    static constexpr int NKIND = 3;
    __device__ __forceinline__ void operands(const Unit& u, const char*& cA, const char*& cB, int& kind) const {
        const char* a = (const char*)A + (size_t)u.pm * 256 * K * 2; const char* b = (const char*)Bt + (size_t)u.pn * 256 * K * 2;
        const bool sw = (u.pn >= 24 && u.pn < 36);
        cA = sw ? b : a; cB = sw ? a : b; kind = sw ? ((u.pn - 24) >> 2) : 0; }
    __device__ __forceinline__ int brow(int kind, int cl) const { return kind == 0 ? cl : (kind == 1 ? 4 * (cl & 31) + (cl >> 5) : 16 * (cl & 7) + (cl >> 3)); }
};

struct EpiF32 {
    static constexpr bool PERM = false;
    float* C; int ldc;
    __device__ __forceinline__ void operator()(const f32x4 (&acc)[2][2][4][2], const Unit& u, int wr, int wc, int fr, int fq) const {
        const int row0 = u.pm * BM + wr * 64 + fr, col0 = u.pn * BM + wc * 32 + 4 * fq;
#pragma unroll
        for (int ai = 0; ai < 2; ++ai)
#pragma unroll
            for (int m = 0; m < 4; ++m) { float* rowp = C + (size_t)(row0 + ai * HALF + m * 16) * ldc + col0;
#pragma unroll
                for (int bj = 0; bj < 2; ++bj)
#pragma unroll
                    for (int n = 0; n < 2; ++n) *(f32x4*)(rowp + bj * HALF + n * 16) = acc[ai][bj][m][n]; }
    }
};
struct EpiInProj {
    static constexpr bool PERM = true;
    bf16 *Qh, *Kh, *VTh, *SZh;
    __device__ __forceinline__ void operator()(const f32x4 (&acc)[2][2][4][2], const Unit& u, int wr, int wc, int fr, int fq) const {
        if (u.pn < 24) {
            const int tq = u.pn >= 12 ? 1 : 0, pnn = u.pn - 12 * tq, g = pnn >> 2, sh = 2 * g, hq = (pnn & 3) * 4;
            const float sc = tq ? 1.f : C2; bf16* base = tq ? Kh : Qh;
#pragma unroll
            for (int ai = 0; ai < 2; ++ai)
#pragma unroll
                for (int m = 0; m < 4; ++m) {
                    const int rowl = u.pm * BM + ai * HALF + wr * 64 + m * 16 + fr, bl = rowl >> 11, t = rowl & 2047;
                    const int row = (t & ((1 << sh) - 1)) * (2048 >> sh) + (t >> sh);
#pragma unroll
                    for (int bj = 0; bj < 2; ++bj) { const int c8 = bj * HALF + wc * 32 + 8 * fq, hh = hq + (c8 >> 6), e0 = c8 & 63;
                        bf16* dst = base + (size_t)((bl * 3 + g) * 16 + hh) * 131072 + qk_off(row, e0, tq);
                        *(u32x4*)dst = pack8(acc[ai][bj][m][0] * sc, acc[ai][bj][m][1] * sc); } }
        } else if (u.pn < 36) {
            const int pv = u.pn - 24, g = pv >> 2, hq = (pv & 3) * 4, bl = u.pm >> 3, t0 = (u.pm & 7) * 256;
#pragma unroll
            for (int ai = 0; ai < 2; ++ai)
#pragma unroll
                for (int m = 0; m < 4; ++m) {
                    const int r = ai * HALF + wr * 64 + m * 16 + fr, hh = hq + (r >> 6), e = r & 63;
                    bf16* rowp = VTh + (size_t)((bl * 3 + g) * 16 + hh) * 131072 + e * 8;
#pragma unroll
                    for (int bj = 0; bj < 2; ++bj) { const int th = t0 + HALF * bj;
                        const int pos = g == 0 ? th + 32 * wc + 8 * fq : (g == 1 ? wc * 512 + (th >> 2) + 8 * fq : (4 * wc + fq) * 128 + (th >> 4));
                        *(u32x4*)(rowp + (pos >> 3) * 512) = pack8(acc[ai][bj][m][0], acc[ai][bj][m][1]); } }
        } else {
#pragma unroll
            for (int ai = 0; ai < 2; ++ai)
#pragma unroll
                for (int m = 0; m < 4; ++m) {
                    const int rowl = u.pm * BM + ai * HALF + wr * 64 + m * 16 + fr;
#pragma unroll
                    for (int bj = 0; bj < 2; ++bj) { const int col = (u.pn - 36) * BM + bj * HALF + wc * 32 + 8 * fq;
                        f32x4 v0 = acc[ai][bj][m][0], v1 = acc[ai][bj][m][1];
#pragma unroll
                        for (int j = 0; j < 4; ++j) { v0[j] = silu_f(v0[j]); v1[j] = silu_f(v1[j]); }
                        *(u32x4*)(SZh + (size_t)rowl * 1024 + col) = pack8(v0, v1); } }
        }
    }
};
struct EpiSsmIn {
    static constexpr bool PERM = true;
    bf16 *UG, *SZ2;
    __device__ __forceinline__ void operator()(const f32x4 (&acc)[2][2][4][2], const Unit& u, int wr, int wc, int fr, int fq) const {
#pragma unroll
        for (int ai = 0; ai < 2; ++ai)
#pragma unroll
            for (int m = 0; m < 4; ++m) {
                const int row = u.pm * BM + ai * HALF + wr * 64 + m * 16 + fr, b = row >> 11, t = row & 2047;
#pragma unroll
                for (int bj = 0; bj < 2; ++bj) { const int col = u.pn * BM + bj * HALF + wc * 32 + 8 * fq;
                    f32x4 v0 = acc[ai][bj][m][0], v1 = acc[ai][bj][m][1];
                    if (u.pn < 4) { const int g = col >> 4, c0 = col & 15; *(u32x4*)(UG + ((size_t)(b * 64 + g) * 2048 + t) * 16 + c0) = pack8(v0, v1); }
                    else {
#pragma unroll
                        for (int j = 0; j < 4; ++j) { v0[j] = silu_f(v0[j]); v1[j] = silu_f(v1[j]); }
                        *(u32x4*)(SZ2 + (size_t)row * 1024 + (col - 1024)) = pack8(v0, v1); } } }
    }
};
struct EpiGlu {
    static constexpr bool PERM = true;
    const bf16 *GB, *SZ2; const float* bglu; bf16* Y2;
    __device__ __forceinline__ void operator()(const f32x4 (&acc)[2][2][4][2], const Unit& u, int wr, int wc, int fr, int fq) const {
#pragma unroll
        for (int ai = 0; ai < 2; ++ai)
#pragma unroll
            for (int m = 0; m < 4; ++m) {
                const int row = u.pm * BM + ai * HALF + wr * 64 + m * 16 + fr;
#pragma unroll
                for (int bj = 0; bj < 2; ++bj) { const int col = u.pn * BM + bj * HALF + wc * 32 + 8 * fq; const size_t o = (size_t)row * 1024 + col;
                    const u32x4 gq = *(const u32x4*)(GB + o), sq = *(const u32x4*)(SZ2 + o);
                    const f32x4 b0 = *(const f32x4*)(bglu + col), b1 = *(const f32x4*)(bglu + col + 4);
                    f32x4 v0 = acc[ai][bj][m][0] + b0, v1 = acc[ai][bj][m][1] + b1;
#pragma unroll
                    for (int j = 0; j < 4; ++j) {
                        const unsigned gw0 = gq[j >> 1], sw0 = sq[j >> 1], gw1 = gq[2 + (j >> 1)], sw1 = sq[2 + (j >> 1)];
                        const float g0 = __builtin_bit_cast(float, (j & 1) ? (gw0 & 0xffff0000u) : (gw0 << 16)), s0 = __builtin_bit_cast(float, (j & 1) ? (sw0 & 0xffff0000u) : (sw0 << 16));
                        const float g1 = __builtin_bit_cast(float, (j & 1) ? (gw1 & 0xffff0000u) : (gw1 << 16)), s1 = __builtin_bit_cast(float, (j & 1) ? (sw1 & 0xffff0000u) : (sw1 << 16));
                        v0[j] = g0 * sigmoid_f(v0[j]) * s0; v1[j] = g1 * sigmoid_f(v1[j]) * s1; }
                    *(u32x4*)(Y2 + o) = pack8(v0, v1); } }
    }
};

template <class Epi, class Prob, bool ALIGN_EPI>
__device__ __forceinline__ void gemm_phase(LAS unsigned char* lds, int wave_id, const Prob P, const StaticOrder& S, const Epi& E) {
    int lane_ = lane_id(); asm volatile("" : "+v"(lane_));
    const int wid = wave_id, lane = lane_, tid = wid * 64 + lane, wr = wid >> 2, wc = wid & 3, fr = lane & 15, fq = lane >> 4;
    const int K = P.K, nt = K / BK;
    unsigned voffA[2], voffB[2];
#pragma unroll
    for (int i = 0; i < 2; ++i) { int R, C; stage_rc(tid * 16 + i * 8192, R, C); voffA[i] = (unsigned)(R * K + C) * 2u; }
#define PG8_SET_VOFFB(kind_) do { int l2_ = lane_id(); asm volatile("" : "+v"(l2_)); const int t2_ = wid * 64 + l2_; _Pragma("unroll") for (int i = 0; i < 2; ++i) { int R, C; stage_rc(t2_ * 16 + i * 8192, R, C); \
        const int cl = Epi::PERM ? ((R & ~31) + perm32(R & 31)) : R; voffB[i] = (unsigned)(P.brow((kind_), cl) * K + C) * 2u; } } while (0)
    const size_t kstep = (size_t)(BK * 2);
    const size_t hstep = (size_t)HALF * K * 2;
    const unsigned ldsw = (unsigned)wid * 1024u;
    const int aoff = lds_byte(wr * 64 + fr, fq * 8), boff = lds_byte(wc * 32 + fr, fq * 8);
#define PG8_SA(b, h) (((b) * 2 + (h)) * HTB)
#define PG8_SB(b, h) ((4 + (b) * 2 + (h)) * HTB)
#define PG8_STAGE(bufoff, gbase, voff) do { _Pragma("unroll") for (int _i = 0; _i < 2; ++_i) \
        __builtin_amdgcn_global_load_lds((const unsigned*)((const char*)(gbase) + (voff)[_i]), (LAS unsigned*)(lds + (bufoff) + ldsw + _i * 8192), 16, 0, 0); } while (0)
#define PG8_LDA(dst, b, h) do { _Pragma("unroll") for (int m = 0; m < 4; ++m) _Pragma("unroll") for (int k = 0; k < 2; ++k) dst[m][k] = *(const LAS bf16x8*)(lds + PG8_SA(b, h) + aoff + m * 2048 + k * 1024); } while (0)
#define PG8_LDB(dst, b, h) do { _Pragma("unroll") for (int n = 0; n < 2; ++n) _Pragma("unroll") for (int k = 0; k < 2; ++k) dst[n][k] = *(const LAS bf16x8*)(lds + PG8_SB(b, h) + boff + n * 2048 + k * 1024); } while (0)
#define PG8_MMA(ai, bj, At, Bt) do { __builtin_amdgcn_s_setprio(1); _Pragma("unroll") for (int m = 0; m < 4; ++m) _Pragma("unroll") for (int n = 0; n < 2; ++n) _Pragma("unroll") for (int k = 0; k < 2; ++k) \
        acc[ai][bj][m][n] = __builtin_amdgcn_mfma_f32_16x16x32_bf16(Bt[n][k], At[m][k], acc[ai][bj][m][n], 0, 0, 0); __builtin_amdgcn_s_setprio(0); } while (0)
#define PG8_WAIT_V(n) asm volatile("s_waitcnt vmcnt(" #n ")" ::: "memory")
#define PG8_WAIT_L(n) asm volatile("s_waitcnt lgkmcnt(" #n ")" ::: "memory")
#define PG8_BAR __builtin_amdgcn_s_barrier()
#define PG8_SCHED __builtin_amdgcn_sched_barrier(0)
    Unit cur, nxt; int ui = 0;
    if (!S.next(0, cur)) return;
    f32x4 acc[2][2][4][2];
#pragma unroll
    for (int a = 0; a < 2; ++a)
#pragma unroll
        for (int b = 0; b < 2; ++b)
#pragma unroll
            for (int m = 0; m < 4; ++m)
#pragma unroll
                for (int n = 0; n < 2; ++n) acc[a][b][m][n] = (f32x4){0.f, 0.f, 0.f, 0.f};
    bf16x8 At[4][2], B0[2][2], B1[2][2];
    const char *cA, *cB; int ckind; P.operands(cur, cA, cB, ckind);
    PG8_SET_VOFFB(ckind);
    PG8_STAGE(PG8_SB(0, 0), cB, voffB); PG8_STAGE(PG8_SB(0, 1), cB + hstep, voffB); PG8_STAGE(PG8_SA(0, 0), cA, voffA); PG8_STAGE(PG8_SA(0, 1), cA + hstep, voffA);
    if (wr == 1) PG8_BAR;
    PG8_WAIT_V(2); PG8_BAR;
    PG8_STAGE(PG8_SB(1, 0), cB + kstep, voffB); PG8_STAGE(PG8_SA(1, 0), cA + kstep, voffA); PG8_STAGE(PG8_SB(1, 1), cB + hstep + kstep, voffB);
    PG8_WAIT_V(6); PG8_BAR;
    for (;;) {
        const bool has_next = S.next(ui + 1, nxt);
        const char *nA = cA, *nB = cB; int nkind = ckind;
        if (has_next) P.operands(nxt, nA, nB, nkind);
        for (int t = 0; t < nt; t += 2) {
            const bool last = (t == nt - 2);
            const char* a1 = cA + (size_t)(t + 1) * kstep;
            const char* a2 = last ? nA : cA + (size_t)(t + 2) * kstep; const char* b2 = last ? nB : cB + (size_t)(t + 2) * kstep;
            const char* a3 = a2 + kstep; const char* b3 = b2 + kstep;
            if (Prob::NKIND > 1 && last && nkind != ckind) PG8_SET_VOFFB(nkind);
            PG8_LDB(B0, 0, 0); PG8_LDB(B1, 0, 1); PG8_SCHED; PG8_LDA(At, 0, 0); PG8_STAGE(PG8_SA(1, 1), a1 + hstep, voffA);
            PG8_WAIT_V(8); PG8_WAIT_L(0); PG8_BAR; PG8_MMA(0, 0, At, B0); PG8_MMA(0, 1, At, B1); PG8_BAR; PG8_SCHED;
            PG8_LDA(At, 0, 1); PG8_STAGE(PG8_SB(0, 0), b2, voffB); PG8_STAGE(PG8_SB(0, 1), b2 + hstep, voffB); PG8_STAGE(PG8_SA(0, 0), a2, voffA);
            PG8_WAIT_V(8); PG8_WAIT_L(0); PG8_BAR; PG8_MMA(1, 0, At, B0); PG8_MMA(1, 1, At, B1); PG8_BAR; PG8_SCHED;
            PG8_LDB(B0, 1, 0); PG8_LDB(B1, 1, 1); PG8_SCHED; PG8_LDA(At, 1, 0); PG8_STAGE(PG8_SA(0, 1), a2 + hstep, voffA);
            PG8_WAIT_V(8); PG8_WAIT_L(0); PG8_BAR; PG8_MMA(0, 0, At, B0); PG8_MMA(0, 1, At, B1); PG8_BAR; PG8_SCHED;
            PG8_LDA(At, 1, 1); PG8_STAGE(PG8_SB(1, 0), b3, voffB); PG8_STAGE(PG8_SB(1, 1), b3 + hstep, voffB); PG8_STAGE(PG8_SA(1, 0), a3, voffA);
            PG8_WAIT_V(8); PG8_WAIT_L(0); PG8_BAR; PG8_MMA(1, 0, At, B0); PG8_MMA(1, 1, At, B1); PG8_BAR; PG8_SCHED;
        }
        if constexpr (ALIGN_EPI) { if (wr == 0) PG8_BAR; }
        E(acc, cur, wr, wc, fr, fq);
        if (!has_next) break;
#pragma unroll
        for (int a = 0; a < 2; ++a)
#pragma unroll
            for (int b = 0; b < 2; ++b)
#pragma unroll
                for (int m = 0; m < 4; ++m)
#pragma unroll
                    for (int n = 0; n < 2; ++n) acc[a][b][m][n] = (f32x4){0.f, 0.f, 0.f, 0.f};
        cur = nxt; cA = nA; cB = nB; ckind = nkind; ++ui;
        if constexpr (ALIGN_EPI) { if (wr == 1) PG8_BAR; }
    }
    PG8_WAIT_V(0);
    if constexpr (!ALIGN_EPI) { if (wr == 0) PG8_BAR; }
    PG8_BAR;
#undef PG8_SET_VOFFB
#undef PG8_SA
#undef PG8_SB
#undef PG8_STAGE
#undef PG8_LDA
#undef PG8_LDB
#undef PG8_MMA
#undef PG8_WAIT_V
#undef PG8_WAIT_L
#undef PG8_BAR
#undef PG8_SCHED
}
}

namespace att {
constexpr int AT_OL = 0, AT_LSE = 131072, AT_TAB = 135168;
constexpr float NEGV = -1e30f;
__device__ __forceinline__ int swap23(int i) { return (i & ~12) | ((i & 4) << 1) | ((i & 8) >> 1); }
__device__ __forceinline__ float swapmax(float m) { return fmaxf(m, __shfl_xor(m, 32)); }
__device__ __forceinline__ float swapsum(float m) { return m + __shfl_xor(m, 32); }
typedef float f32x2_t __attribute__((ext_vector_type(2))); typedef __bf16 bf16x2_t __attribute__((ext_vector_type(2)));
__device__ __forceinline__ unsigned cvtpk(float lo, float hi) { f32x2_t v = {lo, hi}; bf16x2_t b = __builtin_convertvector(v, bf16x2_t); return __builtin_bit_cast(unsigned, b); }
__device__ __forceinline__ int olds_off(int row, int col8) { return row * 128 + ((col8 ^ ((row ^ (row >> 4)) & 15)) << 3); }

__device__ __forceinline__ void task(const bf16* Qb, const bf16* Kb, const bf16* Vb, int pos0, int m0, const LAS float* tab, int lane, f32x16& o0, f32x16& o1, float& mrow, float& lrow) {
    const int q = lane & 31, hi = lane >> 5;
    const int jmin = m0 >= 128 ? 0 : ((128 - m0) >> 5);
    bf16x8 qf[4];
    { const bf16* qp = Qb + (size_t)(pos0 >> 5) * 2048 + lane * 8;
#pragma unroll
      for (int ks = 0; ks < 4; ++ks) qf[ks] = *(const GAS bf16x8*)(qp + ks * 512); }
    const bf16* kp = Kb + ((ptrdiff_t)(pos0 >> 5) - 4) * 2048 + lane * 8;
    bf16x8 kf[5][4];
#pragma unroll
    for (int j = 0; j < 5; ++j) if (j >= jmin) {
#pragma unroll
        for (int ks = 0; ks < 4; ++ks) kf[j][ks] = *(const GAS bf16x8*)(kp + j * 2048 + ks * 512); }
    f32x16 s[5];
#pragma unroll
    for (int j = 0; j < 5; ++j) {
#pragma unroll
        for (int r = 0; r < 16; ++r) s[j][r] = 0.f;
        if (j >= jmin) {
#pragma unroll
            for (int ks = 0; ks < 4; ++ks) s[j] = __builtin_amdgcn_mfma_f32_32x32x16_bf16(kf[j][ks], qf[ks], s[j], 0, 0, 0); } }
    __builtin_amdgcn_sched_barrier(0);
    const bf16* vrow = Vb + ((ptrdiff_t)((pos0 - 128) >> 3) + hi) * 512 + q * 8;
    bf16x8 vf[5][2][2];
#pragma unroll
    for (int j = 0; j < 5; ++j) if (j >= jmin) {
#pragma unroll
        for (int s2 = 0; s2 < 2; ++s2) { vf[j][s2][0] = *(const GAS bf16x8*)(vrow + (4 * j + 2 * s2) * 512); vf[j][s2][1] = *(const GAS bf16x8*)(vrow + (4 * j + 2 * s2) * 512 + 256); } }
    const LAS float* tb = tab + (4 + q - 8 * hi);
    float mx = -3e38f;
#pragma unroll
    for (int j = 0; j < 5; ++j) if (j >= jmin) {
#pragma unroll
        for (int r = 0; r < 16; ++r) { const int cr = (r & 3) + 4 * ((r >> 2) & 1) + 16 * (r >> 3); s[j][r] += tb[155 - 32 * j - cr]; mx = fmaxf(mx, s[j][r]); } }
    mx = swapmax(mx);
    float ls = 0.f;
#pragma unroll
    for (int j = 0; j < 5; ++j) if (j >= jmin) {
#pragma unroll
        for (int r = 0; r < 16; ++r) { const float p = __builtin_amdgcn_exp2f(s[j][r] - mx); s[j][r] = p; ls += p; } }
    ls = swapsum(ls);
#pragma unroll
    for (int r = 0; r < 16; ++r) { o0[r] = 0.f; o1[r] = 0.f; }
#pragma unroll
    for (int j = 0; j < 5; ++j) if (j >= jmin) {
#pragma unroll
        for (int s2 = 0; s2 < 2; ++s2) {
            u32x4 pw; pw.x = cvtpk(s[j][8 * s2 + 0], s[j][8 * s2 + 1]); pw.y = cvtpk(s[j][8 * s2 + 2], s[j][8 * s2 + 3]); pw.z = cvtpk(s[j][8 * s2 + 4], s[j][8 * s2 + 5]); pw.w = cvtpk(s[j][8 * s2 + 6], s[j][8 * s2 + 7]);
            const bf16x8 pf = __builtin_bit_cast(bf16x8, pw);
            o0 = __builtin_amdgcn_mfma_f32_32x32x16_bf16(vf[j][s2][0], pf, o0, 0, 0, 0);
            o1 = __builtin_amdgcn_mfma_f32_32x32x16_bf16(vf[j][s2][1], pf, o1, 0, 0, 0); } }
    mrow = mx; lrow = ls;
}

__device__ __forceinline__ void attn_phase(Frame& F, CArgs args, int half) {
    int lane_ = lane_id(); asm volatile("" : "+v"(lane_));
    const int lane = lane_, wave = F.wave, q = lane & 31, hi = lane >> 5;
    LAS unsigned char* lds = F.lds;
    LAS float* tabs = (LAS float*)(lds + AT_TAB);
    LAS float* lses = (LAS float*)(lds + AT_LSE);
    for (int u = blockIdx.x; u < 256; u += F.G) {
        const int c = u & 3, hh = (u >> 2) & 15, bl = u >> 6;
        for (int i = (F.wave * 64 + lane_id()); i < 3 * 192; i += 512) { const int g = i / 192, idx = i % 192, dist = idx - 31;
            tabs[i] = (dist >= 0 && dist <= 128) ? P_small[SM_BIAS + (g * 16 + hh) * 192 + dist] : NEGV; }
        __syncthreads();
        for (int tk = wave; tk < 32; tk += 8) {
            const int g = tk < 16 ? 2 : 1, k = tk & 15;
            const int r_ = g == 2 ? k : (k >> 2), a = g == 2 ? 0 : (k & 3);
            const int sh = 2 * g, L = 2048 >> sh;
            const int m0 = g == 2 ? 32 * c : 128 * c + 32 * a;
            const size_t hb = (size_t)((bl * 3 + g) * 16 + hh);
            f32x16 o0, o1; float mr, lr;
            task(P_Qh + hb * 131072, P_Kh + hb * 131072, P_VTh + hb * 131072, r_ * L + m0, m0, tabs + g * 192, lane, o0, o1, mr, lr);
            const float inv = 1.f / lr;
            const int row = g == 2 ? 16 * q + r_ : 4 * (32 * a + q) + r_;
            LAS unsigned char* ob = lds + AT_OL + (g == 2 ? 65536 : 0);
#pragma unroll
            for (int d0 = 0; d0 < 2; ++d0)
#pragma unroll
                for (int r4 = 0; r4 < 4; ++r4) { const f32x16& o = d0 ? o1 : o0;
                    u32x2 w; w.x = cvtpk(o[4 * r4] * inv, o[4 * r4 + 1] * inv); w.y = cvtpk(o[4 * r4 + 2] * inv, o[4 * r4 + 3] * inv);
                    *(LAS u32x2*)(ob + olds_off(row, 8 * d0 + 2 * r4 + hi)) = w; }
            if (hi == 0) lses[(g == 2 ? 512 : 0) + row] = mr + log2f(lr);
        }
        __syncthreads();
        for (int j0 = wave; j0 < 16; j0 += 8) {
            const size_t hb = (size_t)((bl * 3 + 0) * 16 + hh);
            f32x16 o0, o1; float mr, lr;
            task(P_Qh + hb * 131072, P_Kh + hb * 131072, P_VTh + hb * 131072, 512 * c + 32 * j0, 512 * c + 32 * j0, tabs, lane, o0, o1, mr, lr);
            const int row = 32 * j0 + q;
            const float l0 = mr + log2f(lr), l1 = lses[row], l2 = lses[512 + row];
            const float mt = fmaxf(fmaxf(l0, l1), l2);
            float w0 = __builtin_amdgcn_exp2f(l0 - mt), w1 = __builtin_amdgcn_exp2f(l1 - mt), w2 = __builtin_amdgcn_exp2f(l2 - mt);
            const float wi = 1.f / (w0 + w1 + w2); w0 *= wi / lr; w1 *= wi; w2 *= wi;
            const size_t ml = (size_t)bl * 2048 + 512 * c + row;
            const bf16* szp = P_SZh + ml * 1024 + hh * 64; bf16* ogp = P_OG + ((size_t)half * HM + ml) * 1024 + hh * 64;
#pragma unroll
            for (int d0 = 0; d0 < 2; ++d0)
#pragma unroll
                for (int r4 = 0; r4 < 4; ++r4) { const f32x16& o = d0 ? o1 : o0; const int col8 = 8 * d0 + 2 * r4 + hi;
                    const u32x2 a1 = *(const LAS u32x2*)(lds + AT_OL + olds_off(row, col8)), a2 = *(const LAS u32x2*)(lds + AT_OL + 65536 + olds_off(row, col8));
                    const u32x2 zz = *(const GAS u32x2*)(szp + 4 * col8);
                    float v[4];
#pragma unroll
                    for (int e = 0; e < 4; ++e) {
                        const unsigned x1 = e < 2 ? a1.x : a1.y, x2 = e < 2 ? a2.x : a2.y, xz = e < 2 ? zz.x : zz.y;
                        const float f1 = __builtin_bit_cast(float, (e & 1) ? (x1 & 0xffff0000u) : (x1 << 16)), f2 = __builtin_bit_cast(float, (e & 1) ? (x2 & 0xffff0000u) : (x2 << 16));
                        const float fz = __builtin_bit_cast(float, (e & 1) ? (xz & 0xffff0000u) : (xz << 16));
                        v[e] = (w0 * o[4 * r4 + e] + w1 * f1 + w2 * f2) * fz; }
                    u32x2 w; w.x = cvtpk(v[0], v[1]); w.y = cvtpk(v[2], v[3]);
                    *(GAS u32x2*)(ogp + 4 * col8) = w; }
        }
        __syncthreads();
    }
}
}

namespace s5 {
constexpr int SU = 0, UROW = 528, SS = 67584;
__device__ __forceinline__ void scan_phase(Frame& F, CArgs args) {
    const int lane = lane_id(), wave = F.wave, q = lane & 31, hi = lane >> 5, tid = wave * 64 + lane;
    LAS unsigned char* lds = F.lds;
    LAS float* Sx = (LAS float*)(lds + SS);
    int ui = 0;
    for (int u = blockIdx.x; u < 512; u += F.G, ++ui) {
        const int g = u & 63, b = u >> 6;
        const bf16* Ug = P_UG + (size_t)(b * 64 + g) * 2048 * 16;
#pragma unroll
        for (int i = 0; i < 8; ++i) { const int idx = tid + 512 * i; const u32x4 v = *(const GAS u32x4*)(Ug + (size_t)idx * 8); *(LAS u32x4*)(lds + SU + (idx >> 5) * UROW + (idx & 31) * 16) = v; }
        __syncthreads();
        {
            const int nb = wave & 3;
            const bf16* w1p = WSB(WS_W1) + ((size_t)g * 128 + 32 * nb + q) * 256 + 8 * hi;
            bf16x8 bfr[16];
#pragma unroll
            for (int ks = 0; ks < 16; ++ks) bfr[ks] = *(const GAS bf16x8*)(w1p + 16 * ks);
#pragma unroll
            for (int cbi = 0; cbi < 2; ++cbi) { const int cb = 2 * (wave >> 2) + cbi; f32x16 acc = {};
                const LAS unsigned char* ap = lds + SU + (32 * cb + q) * UROW + 16 * hi;
#pragma unroll
                for (int ks = 0; ks < 16; ++ks) { const bf16x8 a = *(const LAS bf16x8*)(ap + 32 * ks); acc = __builtin_amdgcn_mfma_f32_32x32x16_bf16(a, bfr[ks], acc, 0, 0, 0); }
#pragma unroll
                for (int r = 0; r < 16; ++r) Sx[(32 * cb + (r & 3) + 8 * (r >> 2) + 4 * hi) * 128 + 32 * nb + q] = acc[r]; }
        }
        __syncthreads();
        const int nb3 = (ui & 1) ? 7 - wave : wave;
        bf16x8 wy[24];
        { const bf16* wyp = WSB(WS_WY) + ((size_t)g * 256 + 32 * nb3 + q) * 384 + 8 * hi;
#pragma unroll
          for (int ks = 0; ks < 16; ++ks) if (ks <= 2 * nb3 + 1) wy[ks] = *(const GAS bf16x8*)(wyp + 16 * ks);
#pragma unroll
          for (int ks = 16; ks < 24; ++ks) wy[ks] = *(const GAS bf16x8*)(wyp + 16 * ks); }
        if (wave == 0) {
            const int p = lane;
            const float lr = P_small[SM_LAMT + 2 * (g * 64 + p)], li = P_small[SM_LAMT + 2 * (g * 64 + p) + 1];
            float xr = 0.f, xi = 0.f;
            for (int c0 = 0; c0 < 128; c0 += 8) {
                float sr[8], si[8];
#pragma unroll
                for (int j = 0; j < 8; ++j) { sr[j] = Sx[(c0 + j) * 128 + p]; si[j] = Sx[(c0 + j) * 128 + 64 + p]; }
                asm volatile("" ::: "memory");
#pragma unroll
                for (int j = 0; j < 8; ++j) { const int c = c0 + j;
                    LAS unsigned char* row = lds + SS + c * 512;
                    *(LAS unsigned short*)(row + ((((p >> 3)) ^ (c & 15)) << 4) + (p & 7) * 2) = (unsigned short)f2bf(xr);
                    *(LAS unsigned short*)(row + (((8 + (p >> 3)) ^ (c & 15)) << 4) + (p & 7) * 2) = (unsigned short)f2bf(xi);
                    const float nr = lr * xr - li * xi + sr[j], ni = lr * xi + li * xr + si[j]; xr = nr; xi = ni; }
                asm volatile("" ::: "memory");
            }
        }
        __syncthreads();
        {
#pragma unroll 1
            for (int cb = 0; cb < 4; ++cb) { f32x16 acc = {};
                const int crow_ = 32 * cb + q;
                const LAS unsigned char* ap = lds + SU + crow_ * UROW + 16 * hi;
#pragma unroll
                for (int ks = 0; ks < 16; ++ks) if (ks <= 2 * nb3 + 1) { const bf16x8 a = *(const LAS bf16x8*)(ap + 32 * ks); acc = __builtin_amdgcn_mfma_f32_32x32x16_bf16(a, wy[ks], acc, 0, 0, 0); }
                const LAS unsigned char* xp = lds + SS + crow_ * 512;
#pragma unroll
                for (int k2 = 0; k2 < 8; ++k2) { const bf16x8 a = *(const LAS bf16x8*)(xp + (((2 * k2 + hi) ^ (crow_ & 15)) << 4)); acc = __builtin_amdgcn_mfma_f32_32x32x16_bf16(a, wy[16 + k2], acc, 0, 0, 0); }
                const int tau = 2 * nb3 + (q >> 4), co = q & 15;
#pragma unroll
                for (int r = 0; r < 16; ++r) { const int chunk = 32 * cb + (r & 3) + 8 * (r >> 2) + 4 * hi;
                    P_GB[((size_t)b * 2048 + 16 * chunk + tau) * 1024 + g * 16 + co] = (bf16)f2bf(gelu_tanh_f(acc[r])); } }
        }
        __syncthreads();
    }
}
}

__device__ __forceinline__ void naive_attn(Frame& F, CArgs args, int half) {
    const int gw = blockIdx.x * 8 + F.wave, NGW = F.G * 8, lane = lane_id();
    const float* bias = P_small + SM_BIAS;
    for (int it = gw; it < 4 * 2048 * 16; it += NGW) {
        const int hh = it & 15, t = (it >> 4) & 2047, bl = it >> 15;
        float og[3], lse[3];
#pragma unroll
        for (int g = 0; g < 3; ++g) {
            const int sh = 2 * g, L = 2048 >> sh, r_ = t & ((1 << sh) - 1), m_ = t >> sh;
            const size_t hb = (size_t)((bl * 3 + g) * 16 + hh);
            const int posq = r_ * L + m_;
            const float qe = bf2f(P_Qh[hb * 131072 + qk_off(posq, lane, 0)]);
            float s0 = -INFINITY, s1 = -INFINITY, s2 = -INFINITY;
            const int jmax = m_ < 128 ? m_ : 128;
            const float* bt = bias + (g * 16 + hh) * 192;
            for (int j = 0; j <= jmax; ++j) {
                const float kv = bf2f(P_Kh[hb * 131072 + qk_off(posq - j, lane, 1)]);
                const float tot = wave_sum(qe * kv) + bt[j];
                if (j < 64) { if (lane == j) s0 = tot; } else if (j < 128) { if (lane == j - 64) s1 = tot; } else { if (lane == 0) s2 = tot; }
            }
            const float mx = wave_max(fmaxf(fmaxf(s0, s1), s2));
            const float p0 = exp2f(s0 - mx), p1 = exp2f(s1 - mx), p2 = exp2f(s2 - mx);
            const float sum = wave_sum(p0 + p1 + p2);
            float o = 0.f;
            const bf16* vp = P_VTh + hb * 131072;
            for (int j = 0; j <= jmax; ++j) {
                const float pj = __shfl(j < 64 ? p0 : (j < 128 ? p1 : p2), j & 63);
                o += pj * bf2f(vp[vt_off(posq - j, lane)]);
            }
            og[g] = o / sum; lse[g] = mx + log2f(sum);
        }
        const float mx = fmaxf(fmaxf(lse[0], lse[1]), lse[2]);
        const float w0 = exp2f(lse[0] - mx), w1 = exp2f(lse[1] - mx), w2 = exp2f(lse[2] - mx);
        const float o = (w0 * og[0] + w1 * og[1] + w2 * og[2]) / (w0 + w1 + w2);
        const size_t ml = (size_t)bl * 2048 + t;
        const float sz = bf2f(P_SZh[ml * 1024 + hh * 64 + lane]);
        P_OG[((size_t)half * HM + ml) * 1024 + hh * 64 + lane] = (bf16)f2bf(o * sz);
    }
}

__device__ __forceinline__ void naive_scan(Frame& F, CArgs args) {
    const int gw = blockIdx.x * 8 + F.wave, NGW = F.G * 8, lane = lane_id();
    for (int it = gw; it < 8 * 64; it += NGW) {
        const int g = it & 63, b = it >> 6;
        const int gp = g * 64 + lane;
        const float lr = P_small[SM_LAM + 2 * gp], li = P_small[SM_LAM + 2 * gp + 1];
        float xr = 0.f, xi = 0.f;
        const bf16* up = P_UG + (size_t)(b * 64 + g) * 2048 * 16;
        const float dsk = P_dskip[g * 16 + (lane & 15)];
        float bbr[16], bbi[16], ccr[16], cci[16];
#pragma unroll
        for (int c = 0; c < 16; ++c) { bbr[c] = P_small[SM_BBAR + (gp * 16 + c) * 2]; bbi[c] = P_small[SM_BBAR + (gp * 16 + c) * 2 + 1];
            ccr[c] = P_c_re[(g * 16 + c) * 64 + lane]; cci[c] = P_c_im[(g * 16 + c) * 64 + lane]; }
        for (int t = 0; t < 2048; ++t) {
            float bur = 0.f, bui = 0.f;
            float uown = 0.f;
#pragma unroll
            for (int c = 0; c < 16; ++c) {
                const float u = bf2f(up[t * 16 + c]);
                bur += bbr[c] * u; bui += bbi[c] * u;
                if ((lane & 15) == c) uown = u;
            }
            const float nr = lr * xr - li * xi + bur, ni = lr * xi + li * xr + bui;
            xr = nr; xi = ni;
            float yown = 0.f;
#pragma unroll
            for (int c = 0; c < 16; ++c) {
                const float v = ccr[c] * xr - cci[c] * xi;
                const float tot = wave_sum(v);
                if ((lane & 15) == c) yown = tot;
            }
            if (lane < 16) {
                const float y = yown + dsk * uown;
                P_GB[((size_t)b * 2048 + t) * 1024 + g * 16 + lane] = (bf16)f2bf(gelu_tanh_f(y));
            }
        }
    }
}

__device__ __forceinline__ void row_pass1(Frame& F, CArgs args) {
    const int gw = blockIdx.x * 8 + F.wave, NGW = F.G * 8, lane = lane_id();
    for (int m = gw; m < M; m += NGW) {
        const GAS f32x4* hr = (const GAS f32x4*)(P_H2 + (size_t)m * D) + lane; const GAS f32x4* xr = (const GAS f32x4*)(P_x + (size_t)m * D) + lane;
        const GAS f32x4* g1 = (const GAS f32x4*)P_attn_post + lane; const GAS f32x4* g2 = (const GAS f32x4*)P_ssm_pre + lane;
        f32x4 v[4]; float s = 0.f;
#pragma unroll
        for (int j = 0; j < 4; ++j) { v[j] = hr[64 * j]; s += (v[j].x * v[j].x + v[j].y * v[j].y) + (v[j].z * v[j].z + v[j].w * v[j].w); }
        const float rs = 1.f / sqrtf(wave_sum(s) * (1.f / D) + EPS);
        float s2 = 0.f;
#pragma unroll
        for (int j = 0; j < 4; ++j) { v[j] = xr[64 * j] + v[j] * rs * g1[64 * j]; s2 += (v[j].x * v[j].x + v[j].y * v[j].y) + (v[j].z * v[j].z + v[j].w * v[j].w); }
        const float rs2 = 1.f / sqrtf(wave_sum(s2) * (1.f / D) + EPS);
        GAS f32x4* o = (GAS f32x4*)(P_out + (size_t)m * D) + lane;
        GAS unsigned long long* o8 = (GAS unsigned long long*)(P_XN2 + (size_t)m * D) + lane;
#pragma unroll
        for (int j = 0; j < 4; ++j) { o[64 * j] = v[j]; const f32x4 g = g2[64 * j];
            o8[64 * j] = (unsigned long long)pk2(v[j].x * rs2 * g.x, v[j].y * rs2 * g.y) | ((unsigned long long)pk2(v[j].z * rs2 * g.z, v[j].w * rs2 * g.w) << 32); }
    }
}
__device__ __forceinline__ void row_pass2(Frame& F, CArgs args) {
    const int gw = blockIdx.x * 8 + F.wave, NGW = F.G * 8, lane = lane_id();
    for (int m = gw; m < M; m += NGW) {
        const GAS f32x4* hr = (const GAS f32x4*)(P_H3 + (size_t)m * D) + lane; GAS f32x4* o = (GAS f32x4*)(P_out + (size_t)m * D) + lane;
        const GAS f32x4* g1 = (const GAS f32x4*)P_ssm_post + lane;
        f32x4 v[4]; float s = 0.f;
#pragma unroll
        for (int j = 0; j < 4; ++j) { v[j] = hr[64 * j]; s += (v[j].x * v[j].x + v[j].y * v[j].y) + (v[j].z * v[j].z + v[j].w * v[j].w); }
        const float rs = 1.f / sqrtf(wave_sum(s) * (1.f / D) + EPS);
#pragma unroll
        for (int j = 0; j < 4; ++j) o[64 * j] = o[64 * j] + v[j] * rs * g1[64 * j];
    }
}

__global__ void __launch_bounds__(512, 2) mk_fwd(Args kargs_unused) {
    CArgs args = (CArgs)__builtin_amdgcn_kernarg_segment_ptr();
    extern __shared__ __attribute__((aligned(16))) unsigned char lds[];
    Frame F;
    F.lds = (LAS unsigned char*)lds;
    F.wave = __builtin_amdgcn_readfirstlane(threadIdx.x >> 6);
    F.G = gridDim.x;
    gu32* ctl = (gu32*)(args->ws + WS_CTL);
    volatile LAS unsigned* MISC = (volatile LAS unsigned*)(F.lds + MISC_OFF);
    for (int u = (F.wave * 64 + lane_id()); u < (LDS_BYTES - LDSCTL_OFF) / 4; u += 512) ((LAS unsigned*)(F.lds + LDSCTL_OFF))[u] = 0u;
    __syncthreads();
    XcdBarrier bar; bar.bar = (unsigned*)(ctl + CW_BAR); bar.x = 0; bar.st = nullptr;
    if (N_LAUNCHES == 1) bar = xcd_barrier_post((unsigned*)(ctl + CW_BAR), MISC + 8, F.wave);
    const int lo = args->ph_lo, hi = args->ph_hi; (void)lo; (void)hi;
#define OPQ() asm volatile("" : "+s"(args))
#if MK_N_LAUNCHES == 1
#define IN(k) true
#define SEAM(k) xcd_barrier(bar, F.wave)
#else
#define IN(k) (lo <= (k) && (k) < hi)
#define SEAM(k) do { if (IN(k) && IN((k) + 1)) xcd_barrier(bar, F.wave); } while (0)
#endif

    if (IN(0)) REP(0) { OPQ(); p0_prologue(F, args); } SEAM(0);
#pragma unroll
    for (int half = 0; half < 2; ++half) {
        if (IN(1 + 2 * half)) REP(1) { OPQ();
#if OPT_GEMM_IN
            pg8::ProbInProj P{P_XN + (size_t)half * HM * D, P_Wt_in, D}; pg8::StaticOrder S; S.init(HM, NIN, F.G, (int)blockIdx.x);
            pg8::EpiInProj E{P_Qh, P_Kh, P_VTh, P_SZh}; pg8::gemm_phase<pg8::EpiInProj, pg8::ProbInProj, true>(F.lds, F.wave, P, S, E);
#else
            EnInProj E{P_Qh, P_Kh, P_VTh, P_SZh}; naive_gemm(F, P_XN + (size_t)half * HM * D, P_Wt_in, HM, NIN, D, E);
#endif
        } SEAM(1 + 2 * half);
        if (IN(2 + 2 * half)) REP(2) { OPQ();
#if OPT_ATTN
            att::attn_phase(F, args, half);
#else
            naive_attn(F, args, half);
#endif
        } SEAM(2 + 2 * half);
    }
    if (IN(5)) REP(5) { OPQ();
#if OPT_GEMM_AO
        pg8::ProbPlain P{P_OG, P_Wt_ao, D}; pg8::StaticOrder S; S.init(M, D, F.G, (int)blockIdx.x);
        pg8::EpiF32 E{P_H2, D}; pg8::gemm_phase<pg8::EpiF32, pg8::ProbPlain, false>(F.lds, F.wave, P, S, E);
#else
        EnF32 E{P_H2}; naive_gemm(F, P_OG, P_Wt_ao, M, D, D, E);
#endif
    } SEAM(5);
    if (IN(6)) REP(6) { OPQ(); row_pass1(F, args); } SEAM(6);
    if (IN(7)) REP(7) { OPQ();
#if OPT_GEMM_SI
        pg8::ProbPlain P{P_XN2, P_Wt_si, D}; pg8::StaticOrder S; S.init(M, 2 * D, F.G, (int)blockIdx.x);
        pg8::EpiSsmIn E{P_UG, P_SZ2}; pg8::gemm_phase<pg8::EpiSsmIn, pg8::ProbPlain, true>(F.lds, F.wave, P, S, E);
#else
        EnSsmIn E{P_UG, P_SZ2}; naive_gemm(F, P_XN2, P_Wt_si, M, 2 * D, D, E);
#endif
    } SEAM(7);
    if (IN(8)) REP(8) { OPQ();
#if OPT_SCAN
        s5::scan_phase(F, args);
#else
        naive_scan(F, args);
#endif
    } SEAM(8);
    if (IN(9)) REP(9) { OPQ();
#if OPT_GEMM_GLU
        pg8::ProbPlain P{P_GB, P_Wt_glu, D}; pg8::StaticOrder S; S.init(M, D, F.G, (int)blockIdx.x);
        pg8::EpiGlu E{P_GB, P_SZ2, P_b_glu, P_Y2}; pg8::gemm_phase<pg8::EpiGlu, pg8::ProbPlain, false>(F.lds, F.wave, P, S, E);
#else
        EnGlu E{P_GB, P_SZ2, P_b_glu, P_Y2}; naive_gemm(F, P_GB, P_Wt_glu, M, D, D, E);
#endif
    } SEAM(9);
    if (IN(10)) REP(10) { OPQ();
#if OPT_GEMM_SO
        pg8::ProbPlain P{P_Y2, P_Wt_so, D}; pg8::StaticOrder S; S.init(M, D, F.G, (int)blockIdx.x);
        pg8::EpiF32 E{P_H3, D}; pg8::gemm_phase<pg8::EpiF32, pg8::ProbPlain, false>(F.lds, F.wave, P, S, E);
#else
        EnF32 E{P_H3}; naive_gemm(F, P_Y2, P_Wt_so, M, D, D, E);
#endif
    } SEAM(10);
    if (IN(11)) { OPQ(); row_pass2(F, args); }
#undef IN
#undef SEAM
}

extern "C" void kernel_launch(void* const* d_in, const int* in_sizes, int n_in, void* d_out, int out_size, void* d_ws, size_t ws_size, hipStream_t stream) {
    static int grid = 0;
    if (grid == 0) {
        if (n_in != 20 || out_size != M * D || ws_size < WS_END) { fprintf(stderr, "kernel_launch: unexpected shapes n_in %d out %d ws %zu\n", n_in, out_size, ws_size); grid = -1; return; }
        int dev = 0, cus = 0, per_cu = 0;
        if (hipGetDevice(&dev) != hipSuccess || hipDeviceGetAttribute(&cus, hipDeviceAttributeMultiprocessorCount, dev) != hipSuccess) { grid = -1; return; }
        if (hipFuncSetAttribute((const void*)mk_fwd, hipFuncAttributeMaxDynamicSharedMemorySize, LDS_BYTES) != hipSuccess) { fprintf(stderr, "kernel_launch: hipFuncSetAttribute failed\n"); grid = -1; return; }
        if (hipOccupancyMaxActiveBlocksPerMultiprocessor(&per_cu, (const void*)mk_fwd, 512, LDS_BYTES) != hipSuccess || per_cu < 1) { fprintf(stderr, "kernel_launch: occupancy query says %d\n", per_cu); per_cu = 1; }
        (void)hipGetLastError();
        grid = cus;
    }
    if (grid < 0) return;
    (void)hipMemsetAsync((char*)d_ws + WS_CTL, 0, CTL_ZERO_BYTES, stream);
    Args a{};
    for (int i = 0; i < 20; ++i) a.in[i] = (const float*)d_in[i];
    a.out = (float*)d_out; a.ws = (unsigned char*)d_ws;
    for (int li = 0; li < N_LAUNCHES; ++li) {
        a.ph_lo = (N_LAUNCHES == 1) ? 0 : li; a.ph_hi = (N_LAUNCHES == 1) ? NPH : li + 1; a.li = li;
        hipLaunchKernelGGL(mk_fwd, dim3(grid), dim3(512), LDS_BYTES, stream, a);
    }
}
```
